# Optimizing an MI355X kernel written in HIP

```python
import math
import jax, jax.numpy as jnp
from jax import lax
import numpy as np

D_MODEL = 1024
BATCH = 16
SEQ = 4096
DEPTH = 2

N_MIXERS = 2
N_META = 16
N_HEADS = 16
N_KV_HEADS = 4
HEAD_DIM = 64
GQA_GROUP = N_HEADS // N_KV_HEADS
WINDOW = 128
BLOCK = 128
ALIBI_MAX_EXP = 8.0
QKV_DIM = (N_HEADS + 2 * N_KV_HEADS) * HEAD_DIM
SSM_GROUP = 16
SSM_N_GROUPS = D_MODEL // SSM_GROUP
SSM_STATE = 64
DT_MIN = 1e-3
DT_MAX = 1e-1
LAMBDA_RE_MAX = -1e-4
D_FF = 4 * D_MODEL
RMS_EPS = 1e-6
NEG_INF = -1e30
N_ATTN_LAYERS = (DEPTH + 1) // 2
N_SSM_LAYERS = DEPTH // 2

kernel_name = "hybrid_swa_sink_alibi_s5_sqrelu_meta"


def rms_norm(x, w):
    xf = x.astype(jnp.float32)
    y = xf * lax.rsqrt(jnp.mean(xf * xf, axis=-1, keepdims=True) + RMS_EPS)
    return (y * w.astype(jnp.float32)).astype(x.dtype)


def alibi_slopes():
    h = jnp.arange(1, N_HEADS + 1, dtype=jnp.float32)
    return jnp.exp2(-ALIBI_MAX_EXP * h / N_HEADS)


def swa_sink_attention(h, norm_w, w_qkv, sinks, w_o):
    b, l, _ = h.shape
    pad = (-N_META) % BLOCK
    lp = l + pad
    nb = lp // BLOCK
    hn = rms_norm(h, norm_w)
    qkv = hn @ w_qkv
    q, k, v = jnp.split(qkv, [N_HEADS * HEAD_DIM, (N_HEADS + N_KV_HEADS) * HEAD_DIM], axis=-1)
    q = q.reshape(b, l, N_KV_HEADS, GQA_GROUP, HEAD_DIM) * (HEAD_DIM ** -0.5)
    k = k.reshape(b, l, N_KV_HEADS, HEAD_DIM)
    v = v.reshape(b, l, N_KV_HEADS, HEAD_DIM)
    k_meta, v_meta = k[:, :N_META], v[:, :N_META]

    def front_pad(t):
        return jnp.pad(t, [(0, 0), (pad, 0)] + [(0, 0)] * (t.ndim - 2))

    qb = front_pad(q).reshape(b, nb, BLOCK, N_KV_HEADS, GQA_GROUP, HEAD_DIM)
    kb = front_pad(k).reshape(b, nb, BLOCK, N_KV_HEADS, HEAD_DIM)
    vb = front_pad(v).reshape(b, nb, BLOCK, N_KV_HEADS, HEAD_DIM)

    def band(t):
        prev = jnp.pad(t, [(0, 0), (1, 0)] + [(0, 0)] * (t.ndim - 2))[:, :-1]
        return jnp.concatenate([prev, t], axis=2)

    k_band, v_band = band(kb), band(vb)

    blk = jnp.arange(nb)[:, None, None]
    qi = jnp.arange(BLOCK)[None, :, None]
    kj = jnp.arange(2 * BLOCK)[None, None, :]
    q_pos = blk * BLOCK + qi - pad
    k_pos = (blk - 1) * BLOCK + kj - pad
    dist = q_pos - k_pos
    band_ok = (dist >= 0) & (dist < WINDOW) & (k_pos >= N_META)
    meta_ok = jnp.arange(N_META)[None, None, :] <= q_pos

    slopes = alibi_slopes().reshape(N_KV_HEADS, GQA_GROUP)[:, :, None, None]
    alibi = -slopes * dist[:, None, None].astype(jnp.float32)

    s_band = jnp.einsum('bnqkgd,bnskd->bnkgqs', qb, k_band).astype(jnp.float32)
    s_band = jnp.where(band_ok[:, None, None], s_band + alibi, NEG_INF)
    s_meta = jnp.einsum('bnqkgd,bmkd->bnkgqm', qb, k_meta).astype(jnp.float32)
    s_meta = jnp.where(meta_ok[:, None, None], s_meta, NEG_INF)
    sink = jnp.broadcast_to(
        sinks.astype(jnp.float32).reshape(N_KV_HEADS, GQA_GROUP)[None, None, :, :, None, None],
        (b, nb, N_KV_HEADS, GQA_GROUP, BLOCK, 1))
    probs = jax.nn.softmax(jnp.concatenate([s_meta, s_band, sink], axis=-1), axis=-1)
    p_meta = probs[..., :N_META].astype(v.dtype)
    p_band = probs[..., N_META:N_META + 2 * BLOCK].astype(v.dtype)
    out = (jnp.einsum('bnkgqs,bnskd->bnqkgd', p_band, v_band)
           + jnp.einsum('bnkgqm,bmkd->bnqkgd', p_meta, v_meta))
    out = out.reshape(b, lp, N_HEADS * HEAD_DIM)[:, pad:]
    return out @ w_o


def _linear_recurrence_combine(left, right):
    a_i, b_i = left
    a_j, b_j = right
    return (a_j * a_i, a_j * b_i + b_j)


def s5_mixer(h, norm_w, lam_re, lam_im, log_dt, b_re, b_im, c_re, c_im, d_skip, w_glu):
    b, l, _ = h.shape
    u = rms_norm(h, norm_w).astype(jnp.float32).reshape(b, l, SSM_N_GROUPS, SSM_GROUP)
    lam = lax.complex(jnp.minimum(lam_re.astype(jnp.float32), LAMBDA_RE_MAX),
                      lam_im.astype(jnp.float32))
    dt = jnp.exp(log_dt.astype(jnp.float32))[:, None]
    a_bar = jnp.exp(lam * dt)
    b_c = lax.complex(b_re.astype(jnp.float32), b_im.astype(jnp.float32))
    c_c = lax.complex(c_re.astype(jnp.float32), c_im.astype(jnp.float32))
    b_bar = ((a_bar - 1.0) / lam)[:, :, None] * b_c
    bu = jnp.einsum('blgc,gpc->blgp', u.astype(jnp.complex64), b_bar)
    a_seq = jnp.broadcast_to(a_bar[None, None], (1, l, SSM_N_GROUPS, SSM_STATE))
    _, states = lax.associative_scan(_linear_recurrence_combine, (a_seq, bu), axis=1)
    y = jnp.real(jnp.einsum('blgp,gcp->blgc', states, c_c)) \
        + d_skip.astype(jnp.float32).reshape(SSM_N_GROUPS, SSM_GROUP) * u
    y = jax.nn.gelu(y.reshape(b, l, D_MODEL)).astype(h.dtype)
    val, gate = jnp.split(y @ w_glu, 2, axis=-1)
    return val * jax.nn.sigmoid(gate)


def sq_relu_mlp(h, norm_w, w_up, w_down):
    a = jax.nn.relu(rms_norm(h, norm_w) @ w_up)
    return (a * a) @ w_down


def setup_inputs(seed: int = 0) -> dict:
    key = jax.random.key(seed)
    ks = jax.random.split(key, 24)
    f32 = jnp.float32
    na, ns, G, P, C = N_ATTN_LAYERS, N_SSM_LAYERS, SSM_N_GROUPS, SSM_STATE, SSM_GROUP
    x = jax.random.normal(ks[0], (BATCH, SEQ, D_MODEL), f32)
    meta_tokens = jax.random.normal(ks[1], (N_META, D_MODEL), f32)
    attn_norm_w = 1.0 + 0.02 * jax.random.normal(ks[2], (na, D_MODEL), f32)
    attn_w_qkv = jax.random.normal(ks[3], (na, D_MODEL, QKV_DIM), f32) * D_MODEL ** -0.5
    attn_sinks = 0.5 * jax.random.normal(ks[4], (na, N_HEADS), f32)
    attn_w_o = jax.random.normal(ks[5], (na, N_HEADS * HEAD_DIM, D_MODEL), f32) * (N_HEADS * HEAD_DIM) ** -0.5
    ssm_norm_w = 1.0 + 0.02 * jax.random.normal(ks[6], (ns, D_MODEL), f32)
    ssm_lambda_re = -0.5 + 0.01 * jax.random.normal(ks[7], (ns, G, P), f32)
    ssm_lambda_im = jnp.broadcast_to(jnp.pi * jnp.arange(P, dtype=f32), (ns, G, P)) \
        + 0.01 * jax.random.normal(ks[8], (ns, G, P), f32)
    ssm_log_dt = jax.random.uniform(ks[9], (ns, G), f32, math.log(DT_MIN), math.log(DT_MAX))
    ssm_b_re = jax.random.normal(ks[10], (ns, G, P, C), f32) * (2.0 * C) ** -0.5
    ssm_b_im = jax.random.normal(ks[11], (ns, G, P, C), f32) * (2.0 * C) ** -0.5
    ssm_c_re = jax.random.normal(ks[12], (ns, G, C, P), f32) * (2.0 * P) ** -0.5
    ssm_c_im = jax.random.normal(ks[13], (ns, G, C, P), f32) * (2.0 * P) ** -0.5
    ssm_d = jax.random.normal(ks[14], (ns, D_MODEL), f32)
    ssm_w_glu = jax.random.normal(ks[15], (ns, D_MODEL, 2 * D_MODEL), f32) * D_MODEL ** -0.5
    mlp_norm_w = 1.0 + 0.02 * jax.random.normal(ks[16], (DEPTH, D_MODEL), f32)
    mlp_w_up = jax.random.normal(ks[17], (DEPTH, D_MODEL, D_FF), f32) * D_MODEL ** -0.5
    mlp_w_down = jax.random.normal(ks[18], (DEPTH, D_FF, D_MODEL), f32) * D_FF ** -0.5
    final_norm_w = 1.0 + 0.02 * jax.random.normal(ks[19], (D_MODEL,), f32)
    return {"x": x, "meta_tokens": meta_tokens,
            "attn_norm_w": attn_norm_w, "attn_w_qkv": attn_w_qkv,
            "attn_sinks": attn_sinks, "attn_w_o": attn_w_o,
            "ssm_norm_w": ssm_norm_w, "ssm_lambda_re": ssm_lambda_re,
            "ssm_lambda_im": ssm_lambda_im, "ssm_log_dt": ssm_log_dt,
            "ssm_b_re": ssm_b_re, "ssm_b_im": ssm_b_im,
            "ssm_c_re": ssm_c_re, "ssm_c_im": ssm_c_im,
            "ssm_d": ssm_d, "ssm_w_glu": ssm_w_glu,
            "mlp_norm_w": mlp_norm_w, "mlp_w_up": mlp_w_up, "mlp_w_down": mlp_w_down,
            "final_norm_w": final_norm_w}


def reference(x, meta_tokens, attn_norm_w, attn_w_qkv, attn_sinks, attn_w_o,
              ssm_norm_w, ssm_lambda_re, ssm_lambda_im, ssm_log_dt,
              ssm_b_re, ssm_b_im, ssm_c_re, ssm_c_im, ssm_d, ssm_w_glu,
              mlp_norm_w, mlp_w_up, mlp_w_down, final_norm_w):
    b = x.shape[0]
    meta = jnp.broadcast_to(meta_tokens.astype(x.dtype)[None], (b, N_META, D_MODEL))
    h = jnp.concatenate([meta, x], axis=1)
    for i in range(DEPTH):
        j = i // N_MIXERS
        if i % N_MIXERS == 0:
            h = h + swa_sink_attention(h, attn_norm_w[j], attn_w_qkv[j], attn_sinks[j], attn_w_o[j])
        else:
            h = h + s5_mixer(h, ssm_norm_w[j], ssm_lambda_re[j], ssm_lambda_im[j], ssm_log_dt[j],
                             ssm_b_re[j], ssm_b_im[j], ssm_c_re[j], ssm_c_im[j], ssm_d[j], ssm_w_glu[j])
        h = h + sq_relu_mlp(h, mlp_norm_w[i], mlp_w_up[i], mlp_w_down[i])
    return rms_norm(h[:, N_META:], final_norm_w)
```

```cpp
#include <hip/hip_runtime.h>
#include <hip/hip_cooperative_groups.h>
#include <cstdio>
#include <cstdint>
namespace cg = cooperative_groups;

#define LAS __attribute__((address_space(3)))
typedef unsigned short bf16_t;
typedef short bf16x8 __attribute__((ext_vector_type(8)));
typedef float f32x4 __attribute__((ext_vector_type(4)));
typedef float f32x16 __attribute__((ext_vector_type(16)));
typedef unsigned u32x4 __attribute__((ext_vector_type(4)));
typedef unsigned u32x2 __attribute__((ext_vector_type(2)));
typedef float f32x2_t __attribute__((ext_vector_type(2)));
typedef __bf16 bf16x2_t __attribute__((ext_vector_type(2)));

__device__ __forceinline__ unsigned cvtpk(float lo, float hi) { f32x2_t v = {lo, hi}; bf16x2_t b = __builtin_convertvector(v, bf16x2_t); return __builtin_bit_cast(unsigned, b); }
__device__ __forceinline__ float bflo(unsigned w) { return __uint_as_float(w << 16); }
__device__ __forceinline__ float bfhi(unsigned w) { return __uint_as_float(w & 0xffff0000u); }

constexpr int DM = 1024, NB = 16, SEQ = 4096, NMETA = 16, FF = 4096;
constexpr int MREAL = NB * SEQ;
constexpr int MALL = MREAL + 256;
constexpr int NQKV = 1536;
constexpr float EPS = 1e-6f;
constexpr float LOG2E = 1.4426950408889634f;
constexpr int NCH = MREAL / 16;
constexpr int UXLD = 384;

constexpr size_t MiB = 1u << 20;
constexpr size_t WS_WQKV = 0, WS_WO = 3 * MiB, WS_WUP0 = 5 * MiB, WS_WDN0 = 13 * MiB, WS_WGLU = 21 * MiB, WS_WUP1 = 25 * MiB, WS_WDN1 = 33 * MiB;
constexpr size_t WS_BW1 = 41 * MiB, WS_BW2 = 49 * MiB, WS_A16 = 61 * MiB, WS_UM = 61 * MiB + 65536, WS_RS0 = 62 * MiB;
constexpr size_t WS_SS1 = 63 * MiB, WS_SS3 = 68 * MiB, WS_SS4 = 76 * MiB;
constexpr size_t WS_RA = 82 * MiB, WS_RB = 211 * MiB, WS_RC = 340 * MiB;
constexpr size_t WS_Q = WS_RC, WS_K = WS_RC + 129 * MiB, WS_V = WS_RC + 162 * MiB;
constexpr size_t WS_ACT = WS_RC;
constexpr size_t WS_UX = WS_RC, WS_S = WS_RC + 192 * MiB, WS_Y = WS_RC + 320 * MiB;
constexpr size_t WS_END = WS_RC + 514 * MiB;

namespace pg8 {
constexpr int BM = 256, BK = 64, HALF = 128, HTB = HALF * BK * 2, STAGE_BYTES = 8 * HTB, NXCD = 8, WGM = 8;
__host__ __device__ __forceinline__ int lds_byte(int r, int c) { const int st = (r >> 4) * 2 + (c >> 5), rr = r & 15, cc = c & 31, ob = rr * 64 + cc * 2; return st * 1024 + (ob ^ (((ob >> 9) & 1) << 5)); }
__host__ __device__ __forceinline__ void stage_rc(int b, int& R, int& C) { const int st = b / 1024, sb = b % 1024, swz = sb ^ (((sb >> 9) & 1) << 5); R = (st >> 1) * 16 + swz / 64; C = (st & 1) * 32 + (swz % 64) / 2; }
__host__ __device__ __forceinline__ int perm32(int rho) { const int n = rho >> 4, i = rho & 15; return 8 * (i >> 2) + 4 * n + (i & 3); }

struct Unit { int pm, pn, pb; };
struct Gemm { const bf16_t* A; const bf16_t* Bt; int K, lda, ldb; size_t bsA, bsB; };

struct StaticOrder {
    int nM, nN, nwg, G, c;
    __device__ void init(int M, int N, int G_, int c_) { nM = M / BM; nN = N / BM; nwg = nM * nN; G = G_; c = c_; }
    __device__ bool next(int i, Unit& u) const {
        const long L = (long)i * G + c; if (L >= nwg) return false;
        int wgid = (int)L; { const int q = nwg / NXCD, r = nwg % NXCD, xcd = wgid % NXCD, off = wgid / NXCD; wgid = (xcd < r ? xcd * (q + 1) : r * (q + 1) + (xcd - r) * q) + off; }
        const int nig = WGM * nN, gid = wgid / nig, fm = gid * WGM, gsz = (nM - fm) < WGM ? (nM - fm) : WGM;
        u.pm = fm + ((wgid % nig) % gsz); u.pn = (wgid % nig) / gsz; u.pb = 0; return true;
    }
};
struct BatchOrder {
    int G, c;
    __device__ bool next(int i, Unit& u) const { const int L = i * G + c; if (L >= 64 * 16) return false; u.pb = L >> 4; u.pm = L & 15; u.pn = 0; return true; }
};

template <class Epi, class Sched>
__device__ __forceinline__ void gemm_phase(LAS unsigned char* lds, const Gemm g, const Sched& S, const Epi& E) {
    int tid_ = threadIdx.x; asm volatile("" : "+v"(tid_));
    const int tid = tid_, wid = __builtin_amdgcn_readfirstlane(tid >> 6), lane = tid & 63, wr = wid >> 2, wc = wid & 3, fr = lane & 15, fq = lane >> 4;
    const int K = g.K, nt = K / BK;
    unsigned voffA[2], voffB[2];
#pragma unroll
    for (int i = 0; i < 2; ++i) { int R, C; stage_rc(tid * 16 + i * 8192, R, C); const int Rb = (R & ~31) + perm32(R & 31);
        voffA[i] = (unsigned)(R * g.lda + C) * 2u; voffB[i] = (unsigned)(Rb * g.ldb + C) * 2u; }
    const size_t kstep = (size_t)(BK * 2);
    const size_t hA = (size_t)HALF * g.lda * 2, hB = (size_t)HALF * g.ldb * 2;
    const size_t tA = 2 * hA, tB = 2 * hB;
    const unsigned ldsw = (unsigned)wid * 1024u;
    const int aoff = lds_byte(wr * 64 + fr, fq * 8), boff = lds_byte(wc * 32 + fr, fq * 8);
#define PG8_SA(b, h) (((b) * 2 + (h)) * HTB)
#define PG8_SB(b, h) ((4 + (b) * 2 + (h)) * HTB)
#define PG8_STAGE(bufoff, gbase, voff) do { _Pragma("unroll") for (int _i = 0; _i < 2; ++_i) \
        __builtin_amdgcn_global_load_lds((const unsigned*)((const char*)(gbase) + (voff)[_i]), (LAS unsigned*)(lds + (bufoff) + ldsw + _i * 8192), 16, 0, 0); } while (0)
#define PG8_LDA(dst, b, h) do { _Pragma("unroll") for (int m = 0; m < 4; ++m) _Pragma("unroll") for (int k = 0; k < 2; ++k) dst[m][k] = *(const LAS bf16x8*)(lds + PG8_SA(b, h) + aoff + m * 2048 + k * 1024); } while (0)
#define PG8_LDB(dst, b, h) do { _Pragma("unroll") for (int n = 0; n < 2; ++n) _Pragma("unroll") for (int k = 0; k < 2; ++k) dst[n][k] = *(const LAS bf16x8*)(lds + PG8_SB(b, h) + boff + n * 2048 + k * 1024); } while (0)
#define PG8_MMA(ai, bj, At, Bt) do { __builtin_amdgcn_s_setprio(1); _Pragma("unroll") for (int m = 0; m < 4; ++m) _Pragma("unroll") for (int n = 0; n < 2; ++n) _Pragma("unroll") for (int k = 0; k < 2; ++k) \
        acc[ai][bj][m][n] = __builtin_amdgcn_mfma_f32_16x16x32_bf16(Bt[n][k], At[m][k], acc[ai][bj][m][n], 0, 0, 0); __builtin_amdgcn_s_setprio(0); } while (0)
#define PG8_WAIT_V(n) asm volatile("s_waitcnt vmcnt(" #n ")" ::: "memory")
#define PG8_WAIT_L(n) asm volatile("s_waitcnt lgkmcnt(" #n ")" ::: "memory")
#define PG8_BAR __builtin_amdgcn_s_barrier()
#define PG8_SCHED __builtin_amdgcn_sched_barrier(0)
    Unit cur, nxt; int ui = 0;
    if (!S.next(0, cur)) return;
    f32x4 acc[2][2][4][2];
#pragma unroll
    for (int a = 0; a < 2; ++a)
#pragma unroll
        for (int b = 0; b < 2; ++b)
#pragma unroll
            for (int m = 0; m < 4; ++m)
#pragma unroll
                for (int n = 0; n < 2; ++n) acc[a][b][m][n] = (f32x4){0.f, 0.f, 0.f, 0.f};
    bf16x8 At[4][2], B0[2][2], B1[2][2];
    const char* cA = (const char*)g.A + (size_t)cur.pb * g.bsA * 2 + (size_t)cur.pm * tA;
    const char* cB = (const char*)g.Bt + (size_t)cur.pb * g.bsB * 2 + (size_t)cur.pn * tB;
    PG8_STAGE(PG8_SB(0, 0), cB, voffB); PG8_STAGE(PG8_SB(0, 1), cB + hB, voffB); PG8_STAGE(PG8_SA(0, 0), cA, voffA); PG8_STAGE(PG8_SA(0, 1), cA + hA, voffA);
    if (wr == 1) PG8_BAR;
    PG8_WAIT_V(2); PG8_BAR;
    PG8_STAGE(PG8_SB(1, 0), cB + kstep, voffB); PG8_STAGE(PG8_SA(1, 0), cA + kstep, voffA); PG8_STAGE(PG8_SB(1, 1), cB + hB + kstep, voffB);
    PG8_WAIT_V(6); PG8_BAR;
    for (;;) {
        const bool has_next = S.next(ui + 1, nxt);
        const char* nA = has_next ? (const char*)g.A + (size_t)nxt.pb * g.bsA * 2 + (size_t)nxt.pm * tA : cA;
        const char* nB = has_next ? (const char*)g.Bt + (size_t)nxt.pb * g.bsB * 2 + (size_t)nxt.pn * tB : cB;
        for (int t = 0; t < nt; t += 2) {
            const bool last = (t == nt - 2);
            const char* a1 = cA + (size_t)(t + 1) * kstep;
            const char* a2 = last ? nA : cA + (size_t)(t + 2) * kstep; const char* b2 = last ? nB : cB + (size_t)(t + 2) * kstep;
            const char* a3 = a2 + kstep; const char* b3 = b2 + kstep;
            PG8_LDB(B0, 0, 0); PG8_LDB(B1, 0, 1); PG8_SCHED; PG8_LDA(At, 0, 0); PG8_STAGE(PG8_SA(1, 1), a1 + hA, voffA);
            PG8_WAIT_V(8); PG8_WAIT_L(0); PG8_BAR; PG8_MMA(0, 0, At, B0); PG8_MMA(0, 1, At, B1); PG8_BAR; PG8_SCHED;
            PG8_LDA(At, 0, 1); PG8_STAGE(PG8_SB(0, 0), b2, voffB); PG8_STAGE(PG8_SB(0, 1), b2 + hB, voffB); PG8_STAGE(PG8_SA(0, 0), a2, voffA);
            PG8_WAIT_V(8); PG8_WAIT_L(0); PG8_BAR; PG8_MMA(1, 0, At, B0); PG8_MMA(1, 1, At, B1); PG8_BAR; PG8_SCHED;
            PG8_LDB(B0, 1, 0); PG8_LDB(B1, 1, 1); PG8_SCHED; PG8_LDA(At, 1, 0); PG8_STAGE(PG8_SA(0, 1), a2 + hA, voffA);
            PG8_WAIT_V(8); PG8_WAIT_L(0); PG8_BAR; PG8_MMA(0, 0, At, B0); PG8_MMA(0, 1, At, B1); PG8_BAR; PG8_SCHED;
            PG8_LDA(At, 1, 1); PG8_STAGE(PG8_SB(1, 0), b3, voffB); PG8_STAGE(PG8_SB(1, 1), b3 + hB, voffB); PG8_STAGE(PG8_SA(1, 0), a3, voffA);
            PG8_WAIT_V(8); PG8_WAIT_L(0); PG8_BAR; PG8_MMA(1, 0, At, B0); PG8_MMA(1, 1, At, B1); PG8_BAR; PG8_SCHED;
        }
        if (wr == 0) PG8_BAR;
        E(acc, cur, wr, wc, fr, fq);
        if (!has_next) break;
#pragma unroll
        for (int a = 0; a < 2; ++a)
#pragma unroll
            for (int b = 0; b < 2; ++b)
#pragma unroll
                for (int m = 0; m < 4; ++m)
#pragma unroll
                    for (int n = 0; n < 2; ++n) acc[a][b][m][n] = (f32x4){0.f, 0.f, 0.f, 0.f};
        cur = nxt; cA = nA; cB = nB; ++ui;
        if (wr == 1) PG8_BAR;
    }
    PG8_WAIT_V(0);
    PG8_BAR;
#undef PG8_SA
#undef PG8_SB
#undef PG8_STAGE
#undef PG8_LDA
#undef PG8_LDB
#undef PG8_MMA
#undef PG8_WAIT_V
#undef PG8_WAIT_L
#undef PG8_BAR
#undef PG8_SCHED
}
}
using pg8::Unit;
typedef f32x4 AccT[2][2][4][2];

__device__ __forceinline__ u32x4 pack8(f32x4 v0, f32x4 v1) { u32x4 w; w.x = cvtpk(v0[0], v0[1]); w.y = cvtpk(v0[2], v0[3]); w.z = cvtpk(v1[0], v1[1]); w.w = cvtpk(v1[2], v1[3]); return w; }
__device__ __forceinline__ void unpack8(u32x4 w, f32x4& v0, f32x4& v1) { v0 = (f32x4){bflo(w.x), bfhi(w.x), bflo(w.y), bfhi(w.y)}; v1 = (f32x4){bflo(w.z), bfhi(w.z), bflo(w.w), bfhi(w.w)}; }

template <int NS> __device__ __forceinline__ float row_rs(const float* SS, int r, int fq) {
    float s;
    if (NS == 16) { const f32x4 a = *(const f32x4*)(SS + (size_t)r * 16 + fq * 4); s = (a[0] + a[1]) + (a[2] + a[3]); }
    else { const f32x4 a = *(const f32x4*)(SS + (size_t)r * 32 + fq * 8), b = *(const f32x4*)(SS + (size_t)r * 32 + fq * 8 + 4); s = ((a[0] + a[1]) + (a[2] + a[3])) + ((b[0] + b[1]) + (b[2] + b[3])); }
    s += __shfl_xor(s, 16); s += __shfl_xor(s, 32);
    return __builtin_amdgcn_rsqf(s * (1.0f / DM) + EPS);
}

struct EpiQKV {
    bf16_t* Q; bf16_t* Kb; bf16_t* Vb; const float* rs; float qscale;
    __device__ __forceinline__ void operator()(const AccT& acc, const Unit& u, int wr, int wc, int fr, int fq) const {
        const int row0 = u.pm * 256 + wr * 64 + fr;
        bf16_t* base; int ld, cb; float sc;
        if (u.pn < 4) { base = Q; ld = DM; cb = u.pn * 256; sc = qscale; } else if (u.pn == 4) { base = Kb; ld = 256; cb = 0; sc = 1.f; } else { base = Vb; ld = 256; cb = 0; sc = 1.f; }
        const int col0 = cb + wc * 32 + 8 * fq;
#pragma unroll
        for (int ai = 0; ai < 2; ++ai)
#pragma unroll
            for (int m = 0; m < 4; ++m) { const int r = row0 + ai * 128 + m * 16; const float s = rs[r] * sc; bf16_t* rowp = base + (size_t)r * ld + col0;
#pragma unroll
                for (int bj = 0; bj < 2; ++bj) *(u32x4*)(rowp + bj * 128) = pack8(acc[ai][bj][m][0] * s, acc[ai][bj][m][1] * s); }
    }
};
struct EpiResid {
    const bf16_t* Hin; bf16_t* Hout; float* SS;
    __device__ __forceinline__ void operator()(const AccT& acc, const Unit& u, int wr, int wc, int fr, int fq) const {
        const int row0 = u.pm * 256 + wr * 64 + fr, col0 = u.pn * 256 + wc * 32 + 8 * fq;
#pragma unroll
        for (int ai = 0; ai < 2; ++ai)
#pragma unroll
            for (int m = 0; m < 4; ++m) { const int r = row0 + ai * 128 + m * 16; const size_t off = (size_t)r * DM + col0; float q = 0.f;
#pragma unroll
                for (int bj = 0; bj < 2; ++bj) { f32x4 h0, h1; unpack8(*(const u32x4*)(Hin + off + bj * 128), h0, h1);
                    const f32x4 v0 = acc[ai][bj][m][0] + h0, v1 = acc[ai][bj][m][1] + h1;
                    q += (v0[0] * v0[0] + v0[1] * v0[1]) + (v0[2] * v0[2] + v0[3] * v0[3]) + (v1[0] * v1[0] + v1[1] * v1[1]) + (v1[2] * v1[2] + v1[3] * v1[3]);
                    *(u32x4*)(Hout + off + bj * 128) = pack8(v0, v1); }
                if (SS) { q += __shfl_xor(q, 16); q += __shfl_xor(q, 32); if (fq == 0) SS[(size_t)r * 16 + u.pn * 4 + wc] = q; } }
    }
};
template <int NS> struct EpiUp {
    const float* SS; bf16_t* ACT;
    __device__ __forceinline__ void operator()(const AccT& acc, const Unit& u, int wr, int wc, int fr, int fq) const {
        const int row0 = u.pm * 256 + wr * 64 + fr, col0 = u.pn * 256 + wc * 32 + 8 * fq;
#pragma unroll
        for (int ai = 0; ai < 2; ++ai)
#pragma unroll
            for (int m = 0; m < 4; ++m) { const int r = row0 + ai * 128 + m * 16; const float s = row_rs<NS>(SS, r, fq); bf16_t* rowp = ACT + (size_t)r * FF + col0;
#pragma unroll
                for (int bj = 0; bj < 2; ++bj) { f32x4 v0 = acc[ai][bj][m][0] * s, v1 = acc[ai][bj][m][1] * s;
#pragma unroll
                    for (int i = 0; i < 4; ++i) { const float a = fmaxf(v0[i], 0.f), b = fmaxf(v1[i], 0.f); v0[i] = a * a; v1[i] = b * b; }
                    *(u32x4*)(rowp + bj * 128) = pack8(v0, v1); } }
    }
};
struct EpiS {
    float* S;
    __device__ __forceinline__ void operator()(const AccT& acc, const Unit& u, int wr, int wc, int fr, int fq) const {
        const int row0 = u.pm * 256 + wr * 64 + fr, col0 = wc * 32 + 8 * fq;
#pragma unroll
        for (int ai = 0; ai < 2; ++ai)
#pragma unroll
            for (int m = 0; m < 4; ++m) { const int r = row0 + ai * 128 + m * 16; float* p = S + ((size_t)u.pb * NCH + r) * 128 + col0;
                *(f32x4*)p = acc[ai][0][m][0]; *(f32x4*)(p + 4) = acc[ai][0][m][1]; }
    }
};
__device__ __forceinline__ float gelu_tanh(float x) { const float z = 0.7978845608028654f * (x + 0.044715f * x * x * x); return x * __builtin_amdgcn_rcpf(1.0f + __builtin_amdgcn_exp2f(-2.0f * LOG2E * z)); }
struct EpiY {
    const bf16_t* UX; const float* Dsk; bf16_t* Y;
    __device__ __forceinline__ void operator()(const AccT& acc, const Unit& u, int wr, int wc, int fr, int fq) const {
        const int g = u.pb; const int r0 = u.pm * 256 + wr * 64 + fr; const int colb = wc * 32 + 8 * fq, c0 = colb & 15;
        const f32x4 d0 = *(const f32x4*)(Dsk + g * 16 + c0), d1 = *(const f32x4*)(Dsk + g * 16 + c0 + 4);
        unsigned offU = (unsigned)(((size_t)g * NCH + r0) * UXLD + colb) * 2u;
        unsigned offY = (unsigned)(((size_t)r0 * 16 + (colb >> 4)) * DM + g * 16 + c0) * 2u;
#pragma unroll
        for (int ai = 0; ai < 2; ++ai)
#pragma unroll
            for (int m = 0; m < 4; ++m) {
                asm volatile("" : "+v"(offU), "+v"(offY));
#pragma unroll
                for (int bj = 0; bj < 2; ++bj) {
                    f32x4 u0, u1; unpack8(*(const u32x4*)((const char*)UX + offU + bj * 256), u0, u1);
                    f32x4 v0 = acc[ai][bj][m][0] + d0 * u0, v1 = acc[ai][bj][m][1] + d1 * u1;
#pragma unroll
                    for (int i = 0; i < 4; ++i) { v0[i] = gelu_tanh(v0[i]); v1[i] = gelu_tanh(v1[i]); }
                    *(u32x4*)((char*)Y + offY + bj * (8 * DM * 2)) = pack8(v0, v1); asm volatile("" ::: "memory"); }
                offU += (m == 3 ? 80 : 16) * UXLD * 2; offY += (m == 3 ? 80 : 16) * 16 * DM * 2;
            }
    }
};
struct EpiGLU {
    const bf16_t* Hin; bf16_t* Hout; float* SS;
    __device__ __forceinline__ void operator()(const AccT& acc, const Unit& u, int wr, int wc, int fr, int fq) const {
        const int row0 = u.pm * 256 + wr * 64 + fr, col0 = u.pn * 128 + wc * 32 + 8 * fq;
#pragma unroll
        for (int ai = 0; ai < 2; ++ai)
#pragma unroll
            for (int m = 0; m < 4; ++m) { const int r = row0 + ai * 128 + m * 16; const size_t off = (size_t)r * DM + col0;
                f32x4 h0, h1; unpack8(*(const u32x4*)(Hin + off), h0, h1);
                f32x4 v0, v1;
#pragma unroll
                for (int i = 0; i < 4; ++i) {
                    v0[i] = h0[i] + acc[ai][0][m][0][i] * __builtin_amdgcn_rcpf(1.0f + __builtin_amdgcn_exp2f(-LOG2E * acc[ai][1][m][0][i]));
                    v1[i] = h1[i] + acc[ai][0][m][1][i] * __builtin_amdgcn_rcpf(1.0f + __builtin_amdgcn_exp2f(-LOG2E * acc[ai][1][m][1][i])); }
                float q = (v0[0] * v0[0] + v0[1] * v0[1]) + (v0[2] * v0[2] + v0[3] * v0[3]) + (v1[0] * v1[0] + v1[1] * v1[1]) + (v1[2] * v1[2] + v1[3] * v1[3]);
                *(u32x4*)(Hout + off) = pack8(v0, v1);
                q += __shfl_xor(q, 16); q += __shfl_xor(q, 32); if (fq == 0) SS[(size_t)r * 32 + u.pn * 4 + wc] = q; }
    }
};

struct Params {
    const float* x; const float* meta; const float* attn_nw; const float* wqkv; const float* sinks; const float* wo;
    const float* ssm_nw; const float* lre; const float* lim; const float* logdt; const float* bre; const float* bim; const float* cre; const float* cim; const float* dsk; const float* wglu;
    const float* mlp_nw; const float* wup; const float* wdn; const float* fnw;
    float* out; unsigned char* ws;
};

__device__ __forceinline__ float wave_sum(float v) {
#pragma unroll
    for (int o = 1; o < 64; o <<= 1) v += __shfl_xor(v, o);
    return v;
}

__device__ __forceinline__ void transpose_item(const float* W, int K, int N, bf16_t* WT, const float* kscale, bool glu, LAS float* scr, int item, int lane) {
    const int nblk = N / 32, kb = item / nblk, nb = item % nblk, k0 = 64 * kb, n0 = 32 * nb;
#pragma unroll 8
    for (int i = 0; i < 32; ++i) { const int kk = 2 * i + (lane >> 5); float v = W[(size_t)(k0 + kk) * N + n0 + (lane & 31)]; if (kscale) v *= kscale[k0 + kk]; scr[kk * 33 + (lane & 31)] = v; }
    asm volatile("s_waitcnt lgkmcnt(0)" ::: "memory");
    const int c = lane & 7;
#pragma unroll
    for (int j = 0; j < 4; ++j) { const int n = (lane >> 3) + 8 * j; const LAS float* s = scr + (8 * c) * 33 + n;
        u32x4 o; o.x = cvtpk(s[0 * 33], s[1 * 33]); o.y = cvtpk(s[2 * 33], s[3 * 33]); o.z = cvtpk(s[4 * 33], s[5 * 33]); o.w = cvtpk(s[6 * 33], s[7 * 33]);
        int nd = n0 + n; if (glu) { const int bj = nd >> 10, rem = nd & 1023; nd = (rem >> 7) * 256 + bj * 128 + (rem & 127); }
        *(u32x4*)(WT + (size_t)nd * K + k0 + 8 * c) = o; }
    asm volatile("s_waitcnt lgkmcnt(0)" ::: "memory");
}

struct SsmP { float lr, li, dt; };
__device__ __forceinline__ void cpow(const SsmP& s, float tau, float& re, float& im) { const float mag = expf(s.lr * s.dt * tau); float sn, cs; sincosf(s.li * s.dt * tau, &sn, &cs); re = mag * cs; im = mag * sn; }
__device__ __forceinline__ void ccoef(const SsmP& s, float& re, float& im) {
    float ar, ai; cpow(s, 1.0f, ar, ai); ar -= 1.0f; const float den = 1.0f / (s.lr * s.lr + s.li * s.li);
    re = (ar * s.lr + ai * s.li) * den; im = (ai * s.lr - ar * s.li) * den;
}

constexpr int KS_LD = 72, VT_LD = 296, KS_BYTES = 288 * KS_LD * 2;
__device__ __forceinline__ void attn_phase(LAS unsigned char* lds, bf16_t* Q, const bf16_t* Kb, const bf16_t* Vb, const float* sinks, int vcu, int G) {
    int tid_ = threadIdx.x; asm volatile("" : "+v"(tid_));
    const int tid = tid_, lane = tid & 63, wid = __builtin_amdgcn_readfirstlane(tid >> 6), q = lane & 31, hi = lane >> 5;
    LAS bf16_t* Ks = (LAS bf16_t*)lds; LAS bf16_t* Vt = (LAS bf16_t*)(lds + KS_BYTES);
    const int piq = (q & 0x13) | ((q & 4) << 1) | ((q & 8) >> 1);
#pragma unroll 1
    for (int L = vcu; L < 2052; L += G) {
        const bool meta = L >= 2048;
        int b = 0, kvh, qb = 0;
        if (!meta) { b = L >> 7; kvh = (L >> 5) & 3; qb = L & 31; } else kvh = L - 2048;
        const int t0 = qb * 128;
        __syncthreads();
        for (int i = tid; i < 288 * 8; i += 512) {
            const int kk = i >> 3, ch = i & 7; long row = -1;
            if (kk < 256) { const int s = t0 - 128 + kk; if (!meta && s >= 0) row = (long)b * SEQ + s; } else if (kk < 272) row = MREAL + (kk - 256);
            u32x4 kv = (u32x4){0u, 0u, 0u, 0u}, vv = (u32x4){0u, 0u, 0u, 0u};
            if (row >= 0) { kv = *(const u32x4*)(Kb + row * 256 + kvh * 64 + ch * 8); vv = *(const u32x4*)(Vb + row * 256 + kvh * 64 + ch * 8); }
            *(LAS u32x4*)(Ks + kk * KS_LD + ch * 8) = kv;
            LAS bf16_t* vp = Vt + (ch * 8) * VT_LD + kk;
            vp[0 * VT_LD] = (bf16_t)(vv.x & 0xffffu); vp[1 * VT_LD] = (bf16_t)(vv.x >> 16); vp[2 * VT_LD] = (bf16_t)(vv.y & 0xffffu); vp[3 * VT_LD] = (bf16_t)(vv.y >> 16);
            vp[4 * VT_LD] = (bf16_t)(vv.z & 0xffffu); vp[5 * VT_LD] = (bf16_t)(vv.z >> 16); vp[6 * VT_LD] = (bf16_t)(vv.w & 0xffffu); vp[7 * VT_LD] = (bf16_t)(vv.w >> 16);
        }
        __syncthreads();
        const int hq = kvh * 4 + (wid >> 1);
        const float slope = exp2f(-0.5f * (float)(hq + 1)) * LOG2E, sink = sinks[hq] * LOG2E;
#pragma unroll 1
        for (int it = 0; it < 2; ++it) {
            const int rt = (wid & 1) * 2 + it;
            if (meta && rt != 0) continue;
            const long qrow = meta ? (long)(MREAL + q) : (long)b * SEQ + t0 + 32 * rt + q;
            bf16_t* qp = Q + qrow * DM + hq * 64;
            bf16x8 qf[4];
#pragma unroll
            for (int dk = 0; dk < 4; ++dk) qf[dk] = *(const bf16x8*)(qp + dk * 16 + hi * 8);
            f32x16 S[6];
#pragma unroll
            for (int k6 = 0; k6 < 6; ++k6) { const int kt = (k6 < 5) ? rt + k6 : 8; f32x16 a = {};
                const LAS bf16_t* kp = Ks + (32 * kt + piq) * KS_LD + hi * 8;
#pragma unroll
                for (int dk = 0; dk < 4; ++dk) a = __builtin_amdgcn_mfma_f32_32x32x16_bf16(*(const LAS bf16x8*)(kp + dk * 16), qf[dk], a, 0, 0, 0);
                S[k6] = a; asm volatile("" ::: "memory"); }
            float mx = sink;
            int base = 128 + q - 8 * hi; asm volatile("" : "+v"(base));
            const float fb = (float)base;
            const unsigned lim1 = meta ? 0u : (unsigned)min(128, t0 + 32 * rt + q + 1);
            const int qlim = meta ? q : 15;
#pragma unroll
            for (int k6 = 0; k6 < 6; ++k6)
#pragma unroll
                for (int r = 0; r < 16; ++r) { bool ok; float v;
                    if (k6 < 5) { const int cc = 32 * k6 + (r & 7) + 16 * (r >> 3); const int dist = base - cc; ok = (unsigned)dist < lim1; v = S[k6][r] - slope * (fb - (float)cc); }
                    else { const int kin = (r & 7) + 8 * hi + 16 * (r >> 3); ok = kin <= qlim; v = S[k6][r]; }
                    v = ok ? v : -1e30f; S[k6][r] = v; mx = fmaxf(mx, v); }
            mx = fmaxf(mx, __shfl_xor(mx, 32));
            float l = 0.f;
#pragma unroll
            for (int k6 = 0; k6 < 6; ++k6)
#pragma unroll
                for (int r = 0; r < 16; ++r) { const float p = __builtin_amdgcn_exp2f(S[k6][r] - mx); S[k6][r] = p; l += p; }
            l += __shfl_xor(l, 32); l += __builtin_amdgcn_exp2f(sink - mx);
            f32x16 O[2]; O[0] = f32x16{}; O[1] = f32x16{};
#pragma unroll
            for (int k6 = 0; k6 < 6; ++k6) { const int kt = (k6 < 5) ? rt + k6 : 8;
#pragma unroll
                for (int hf = 0; hf < 2; ++hf) {
                    u32x4 pw; pw.x = cvtpk(S[k6][8 * hf + 0], S[k6][8 * hf + 1]); pw.y = cvtpk(S[k6][8 * hf + 2], S[k6][8 * hf + 3]); pw.z = cvtpk(S[k6][8 * hf + 4], S[k6][8 * hf + 5]); pw.w = cvtpk(S[k6][8 * hf + 6], S[k6][8 * hf + 7]);
                    const bf16x8 pb = __builtin_bit_cast(bf16x8, pw);
#pragma unroll
                    for (int dt = 0; dt < 2; ++dt) { const bf16x8 va = *(const LAS bf16x8*)(Vt + (32 * dt + q) * VT_LD + 32 * kt + 16 * hf + 8 * hi);
                        O[dt] = __builtin_amdgcn_mfma_f32_32x32x16_bf16(va, pb, O[dt], 0, 0, 0); }
                    asm volatile("" ::: "memory"); } }
            const float rl = 1.0f / l;
#pragma unroll
            for (int dt = 0; dt < 2; ++dt)
#pragma unroll
                for (int j = 0; j < 4; ++j) { u32x2 w; w.x = cvtpk(O[dt][4 * j] * rl, O[dt][4 * j + 1] * rl); w.y = cvtpk(O[dt][4 * j + 2] * rl, O[dt][4 * j + 3] * rl);
                    *(u32x2*)(qp + 32 * dt + 8 * j + 4 * hi) = w; }
        }
    }
    __syncthreads();
}

constexpr int LDS_BYTES = 147456;
#ifndef PHMASK
#define PHMASK 0xFFFF
#endif
__global__ void __launch_bounds__(512, 2) fwd_kernel(Params P) {
    extern __shared__ __attribute__((aligned(16))) unsigned char lds_raw[];
    LAS unsigned char* lds = (LAS unsigned char*)lds_raw;
    cg::grid_group grid = cg::this_grid();
    const int tid = threadIdx.x, lane = tid & 63, wave = __builtin_amdgcn_readfirstlane(tid >> 6);
    const int G = gridDim.x, bx = blockIdx.x;
    const int vcu = (G % 8 == 0) ? (bx % 8) * (G / 8) + bx / 8 : bx;
    const int gw = vcu * 8 + wave, NGW = G * 8;
    unsigned char* ws = P.ws;
    bf16_t* Wqkv_t = (bf16_t*)(ws + WS_WQKV); bf16_t* Wo_t = (bf16_t*)(ws + WS_WO); bf16_t* Wup0_t = (bf16_t*)(ws + WS_WUP0); bf16_t* Wdn0_t = (bf16_t*)(ws + WS_WDN0);
    bf16_t* Wglu_t = (bf16_t*)(ws + WS_WGLU); bf16_t* Wup1_t = (bf16_t*)(ws + WS_WUP1); bf16_t* Wdn1_t = (bf16_t*)(ws + WS_WDN1);
    bf16_t* BW1 = (bf16_t*)(ws + WS_BW1); bf16_t* BW2 = (bf16_t*)(ws + WS_BW2); float* A16 = (float*)(ws + WS_A16); bf16_t* UM = (bf16_t*)(ws + WS_UM);
    float* RS0 = (float*)(ws + WS_RS0); float* SS1 = (float*)(ws + WS_SS1); float* SS3 = (float*)(ws + WS_SS3); float* SS4 = (float*)(ws + WS_SS4);
    bf16_t* HA = (bf16_t*)(ws + WS_RA); bf16_t* HB = (bf16_t*)(ws + WS_RB);
    bf16_t* Qb = (bf16_t*)(ws + WS_Q); bf16_t* Kb = (bf16_t*)(ws + WS_K); bf16_t* Vb = (bf16_t*)(ws + WS_V); bf16_t* ACT = (bf16_t*)(ws + WS_ACT);
    bf16_t* UX = (bf16_t*)(ws + WS_UX); float* Sst = (float*)(ws + WS_S); bf16_t* Yb = (bf16_t*)(ws + WS_Y);

    if (PHMASK & 1) {
        int t_ = threadIdx.x; asm volatile("" : "+v"(t_)); const int tid = t_, lane = tid & 63; (void)tid; (void)lane;
        LAS float* scr = (LAS float*)(lds + wave * 16384);
        constexpr int I_QKV = 16 * 48, I_O = 16 * 32, I_UP = 16 * 128, I_DN = 64 * 32, I_GLU = 16 * 64;
        constexpr int NITEMS = I_QKV + I_O + 2 * I_UP + 2 * I_DN + I_GLU;
        for (int it = gw; it < NITEMS; it += NGW) {
            int r = it;
            if (r < I_QKV) { transpose_item(P.wqkv, DM, NQKV, Wqkv_t, P.attn_nw, false, scr, r, lane); continue; } r -= I_QKV;
            if (r < I_O) { transpose_item(P.wo, DM, DM, Wo_t, nullptr, false, scr, r, lane); continue; } r -= I_O;
            if (r < I_UP) { transpose_item(P.wup, DM, FF, Wup0_t, P.mlp_nw, false, scr, r, lane); continue; } r -= I_UP;
            if (r < I_DN) { transpose_item(P.wdn, FF, DM, Wdn0_t, nullptr, false, scr, r, lane); continue; } r -= I_DN;
            if (r < I_GLU) { transpose_item(P.wglu, DM, 2 * DM, Wglu_t, nullptr, true, scr, r, lane); continue; } r -= I_GLU;
            if (r < I_UP) { transpose_item(P.wup + (size_t)DM * FF, DM, FF, Wup1_t, P.mlp_nw + DM, false, scr, r, lane); continue; } r -= I_UP;
            transpose_item(P.wdn + (size_t)FF * DM, FF, DM, Wdn1_t, nullptr, false, scr, r, lane);
        }
        for (int m = gw; m < MALL; m += NGW) {
            unsigned long long* o8 = (unsigned long long*)(HA + (size_t)m * DM) + lane;
            if (m >= MREAL + NMETA) {
#pragma unroll
                for (int j = 0; j < 4; ++j) o8[64 * j] = 0ull;
                if (lane == 0) RS0[m] = 1.0f; continue; }
            const float* src = (m < MREAL) ? P.x + (size_t)m * DM : P.meta + (size_t)(m - MREAL) * DM;
            const f32x4* xr = (const f32x4*)src + lane; f32x4 v[4]; float s = 0.f;
#pragma unroll
            for (int j = 0; j < 4; ++j) { v[j] = xr[64 * j]; s += (v[j].x * v[j].x + v[j].y * v[j].y) + (v[j].z * v[j].z + v[j].w * v[j].w); }
            s = wave_sum(s);
#pragma unroll
            for (int j = 0; j < 4; ++j) o8[64 * j] = (unsigned long long)cvtpk(v[j].x, v[j].y) | ((unsigned long long)cvtpk(v[j].z, v[j].w) << 32);
            if (lane == 0) RS0[m] = 1.0f / sqrtf(s * (1.0f / DM) + EPS);
        }
        const int gt = vcu * 512 + tid, NT = G * 512;
        for (int it = gt; it < 64 * 16 * 16 * 16; it += NT) {
            const int cp = it & 15, si = (it >> 4) & 15, ti = (it >> 8) & 15, g = it >> 12;
            float kv[16];
#pragma unroll
            for (int c = 0; c < 16; ++c) kv[c] = 0.f;
            if (si <= ti) { const float tau = (float)(ti - si); const float dt = expf(P.logdt[g]);
                for (int p = 0; p < 64; ++p) { SsmP s; s.lr = fminf(P.lre[g * 64 + p], -1e-4f); s.li = P.lim[g * 64 + p]; s.dt = dt;
                    float cr, ci, ar, ai; ccoef(s, cr, ci); cpow(s, tau, ar, ai);
                    const float br = P.bre[(g * 64 + p) * 16 + cp], bi = P.bim[(g * 64 + p) * 16 + cp];
                    const float bbr = cr * br - ci * bi, bbi = cr * bi + ci * br;
                    const float wr_ = ar * bbr - ai * bbi, wi_ = ar * bbi + ai * bbr;
#pragma unroll
                    for (int c = 0; c < 16; ++c) kv[c] += P.cre[(g * 16 + c) * 64 + p] * wr_ - P.cim[(g * 16 + c) * 64 + p] * wi_; } }
#pragma unroll
            for (int c = 0; c < 16; ++c) BW2[((size_t)g * 256 + ti * 16 + c) * UXLD + si * 16 + cp] = (bf16_t)(cvtpk(kv[c], 0.f) & 0xffffu);
        }
        for (int it = gt; it < 64 * 16 * 16 * 64; it += NT) {
            const int p = it & 63, c = (it >> 6) & 15, ti = (it >> 10) & 15, g = it >> 14;
            SsmP s; s.lr = fminf(P.lre[g * 64 + p], -1e-4f); s.li = P.lim[g * 64 + p]; s.dt = expf(P.logdt[g]);
            float ar, ai; cpow(s, (float)(ti + 1), ar, ai);
            const float cr = P.cre[(g * 16 + c) * 64 + p], ci = P.cim[(g * 16 + c) * 64 + p];
            *(unsigned*)(BW2 + ((size_t)g * 256 + ti * 16 + c) * UXLD + 256 + 2 * p) = cvtpk(cr * ar - ci * ai, -(cr * ai + ci * ar));
        }
        for (int it = gt; it < 64 * 64 * 16 * 16; it += NT) {
            const int cp = it & 15, si = (it >> 4) & 15, p = (it >> 8) & 63, g = it >> 14;
            SsmP s; s.lr = fminf(P.lre[g * 64 + p], -1e-4f); s.li = P.lim[g * 64 + p]; s.dt = expf(P.logdt[g]);
            float cr, ci, ar, ai; ccoef(s, cr, ci); cpow(s, (float)(15 - si), ar, ai);
            const float br = P.bre[(g * 64 + p) * 16 + cp], bi = P.bim[(g * 64 + p) * 16 + cp];
            const float bbr = cr * br - ci * bi, bbi = cr * bi + ci * br;
            const unsigned w = cvtpk(ar * bbr - ai * bbi, ar * bbi + ai * bbr);
            BW1[((size_t)g * 256 + 2 * p) * 256 + si * 16 + cp] = (bf16_t)(w & 0xffffu);
            BW1[((size_t)g * 256 + 2 * p + 1) * 256 + si * 16 + cp] = (bf16_t)(w >> 16);
        }
        for (int it = gt; it < 64 * 128 * 32; it += NT) { const int ch = it & 31, n = (it >> 5) & 127, g = it >> 12;
            *(u32x4*)(BW1 + ((size_t)g * 256 + 128 + n) * 256 + ch * 8) = (u32x4){0u, 0u, 0u, 0u}; }
        for (int it = gt; it < 64 * 64; it += NT) { const int g = it >> 6;
            SsmP s; s.lr = fminf(P.lre[it], -1e-4f); s.li = P.lim[it]; s.dt = expf(P.logdt[g]);
            float ar, ai; cpow(s, 16.0f, ar, ai); A16[2 * it] = ar; A16[2 * it + 1] = ai; }
    }
    grid.sync();

    if (PHMASK & (1 << 1)) {
        pg8::Gemm g{HA, Wqkv_t, DM, DM, DM, 0, 0}; pg8::StaticOrder S; S.init(MALL, NQKV, G, bx);
        EpiQKV E{Qb, Kb, Vb, RS0, 0.125f * LOG2E};
        pg8::gemm_phase(lds, g, S, E);
    }
    grid.sync();
    if (PHMASK & 4) attn_phase(lds, Qb, Kb, Vb, P.sinks, vcu, G);
    grid.sync();
    if (PHMASK & (1 << 3)) {
        pg8::Gemm g{Qb, Wo_t, DM, DM, DM, 0, 0}; pg8::StaticOrder S; S.init(MALL, DM, G, bx);
        EpiResid E{HA, HB, SS1};
        pg8::gemm_phase(lds, g, S, E);
    }
    grid.sync();
    if (PHMASK & (1 << 4)) {
        pg8::Gemm g{HB, Wup0_t, DM, DM, DM, 0, 0}; pg8::StaticOrder S; S.init(MALL, FF, G, bx);
        EpiUp<16> E{SS1, ACT};
        pg8::gemm_phase(lds, g, S, E);
    }
    grid.sync();
    if (PHMASK & (1 << 5)) {
        pg8::Gemm g{ACT, Wdn0_t, FF, FF, FF, 0, 0}; pg8::StaticOrder S; S.init(MALL, DM, G, bx);
        EpiResid E{HB, HA, nullptr};
        pg8::gemm_phase(lds, g, S, E);
    }
    grid.sync();
    if (PHMASK & (1 << 6)) {
        int t_ = threadIdx.x; asm volatile("" : "+v"(t_)); const int tid = t_, lane = tid & 63; (void)tid; (void)lane;
        f32x4 wv[4];
#pragma unroll
        for (int j = 0; j < 4; ++j) wv[j] = *(const f32x4*)(P.ssm_nw + lane * 16 + 4 * j);
        for (int ch = gw; ch < NCH + 1; ch += NGW) {
            const bool mt = ch == NCH;
            for (int ti = 0; ti < 16; ++ti) {
                const size_t row = mt ? (size_t)(MREAL + ti) : (size_t)ch * 16 + ti;
                const u32x4* hp = (const u32x4*)(HA + row * DM + lane * 16);
                f32x4 v[4]; unpack8(hp[0], v[0], v[1]); unpack8(hp[1], v[2], v[3]);
                float s = 0.f;
#pragma unroll
                for (int j = 0; j < 4; ++j) s += (v[j].x * v[j].x + v[j].y * v[j].y) + (v[j].z * v[j].z + v[j].w * v[j].w);
                s = wave_sum(s); const float rs = 1.0f / sqrtf(s * (1.0f / DM) + EPS);
#pragma unroll
                for (int j = 0; j < 4; ++j) v[j] = v[j] * rs * wv[j];
                bf16_t* dst = mt ? UM + lane * 256 + ti * 16 : UX + ((size_t)lane * NCH + ch) * UXLD + ti * 16;
                *(u32x4*)dst = pack8(v[0], v[1]); *(u32x4*)(dst + 8) = pack8(v[2], v[3]);
            }
        }
    }
    grid.sync();
    if (PHMASK & (1 << 7)) {
        pg8::Gemm g{UX, BW1, 256, UXLD, 256, (size_t)NCH * UXLD, (size_t)256 * 256}; pg8::BatchOrder S{G, bx};
        EpiS E{Sst};
        pg8::gemm_phase(lds, g, S, E);
    }
    grid.sync();
    if (PHMASK & 256) {
        int t_ = threadIdx.x; asm volatile("" : "+v"(t_)); const int tid = t_, lane = tid & 63; (void)tid; (void)lane;
      if (tid < 256) {
        const int item = bx * 256 + tid;
        if (item < NB * 64 * 64) {
            const int p = item & 63, g = (item >> 6) & 63, b = item >> 12;
            const float ar = A16[2 * (g * 64 + p)], ai = A16[2 * (g * 64 + p) + 1];
            float xr = 0.f, xi = 0.f;
            { const bf16_t* um = UM + g * 256; const bf16_t* w0 = BW1 + ((size_t)g * 256 + 2 * p) * 256; const bf16_t* w1 = w0 + 256;
                for (int k = 0; k < 256; k += 8) { f32x4 u0, u1, a0, a1, b0, b1; unpack8(*(const u32x4*)(um + k), u0, u1); unpack8(*(const u32x4*)(w0 + k), a0, a1); unpack8(*(const u32x4*)(w1 + k), b0, b1);
#pragma unroll
                    for (int i = 0; i < 4; ++i) { xr += u0[i] * a0[i] + u1[i] * a1[i]; xi += u0[i] * b0[i] + u1[i] * b1[i]; } } }
            const float* sp = Sst + ((size_t)g * NCH + b * 256) * 128 + 2 * p;
            bf16_t* xp = UX + ((size_t)g * NCH + b * 256) * UXLD + 256 + 2 * p;
            for (int j0 = 0; j0 < 256; j0 += 16) {
                f32x2_t sv[16];
#pragma unroll
                for (int j = 0; j < 16; ++j) sv[j] = *(const f32x2_t*)(sp + (size_t)(j0 + j) * 128);
#pragma unroll
                for (int j = 0; j < 16; ++j) { *(unsigned*)(xp + (size_t)(j0 + j) * UXLD) = cvtpk(xr, xi);
                    const float nr = ar * xr - ai * xi + sv[j].x, ni = ar * xi + ai * xr + sv[j].y; xr = nr; xi = ni; }
            }
        }
      }
    }
    grid.sync();
    if (PHMASK & (1 << 9)) {
        pg8::Gemm g{UX, BW2, UXLD, UXLD, UXLD, (size_t)NCH * UXLD, (size_t)256 * UXLD}; pg8::BatchOrder S{G, bx};
        EpiY E{UX, P.dsk, Yb};
        pg8::gemm_phase(lds, g, S, E);
    }
    grid.sync();
    if (PHMASK & (1 << 10)) {
        pg8::Gemm g{Yb, Wglu_t, DM, DM, DM, 0, 0}; pg8::StaticOrder S; S.init(MREAL, 2 * DM, G, bx);
        EpiGLU E{HA, HB, SS3};
        pg8::gemm_phase(lds, g, S, E);
    }
    grid.sync();
    if (PHMASK & (1 << 11)) {
        pg8::Gemm g{HB, Wup1_t, DM, DM, DM, 0, 0}; pg8::StaticOrder S; S.init(MREAL, FF, G, bx);
        EpiUp<32> E{SS3, ACT};
        pg8::gemm_phase(lds, g, S, E);
    }
    grid.sync();
    if (PHMASK & (1 << 12)) {
        pg8::Gemm g{ACT, Wdn1_t, FF, FF, FF, 0, 0}; pg8::StaticOrder S; S.init(MREAL, DM, G, bx);
        EpiResid E{HB, HA, SS4};
        pg8::gemm_phase(lds, g, S, E);
    }
    grid.sync();
    if (PHMASK & (1 << 13)) {
        int t_ = threadIdx.x; asm volatile("" : "+v"(t_)); const int tid = t_, lane = tid & 63; (void)tid; (void)lane;
      for (int m = gw; m < MREAL; m += NGW) {
        const float sl = (lane < 16) ? SS4[(size_t)m * 16 + lane] : 0.f;
        const float rs = 1.0f / sqrtf(wave_sum(sl) * (1.0f / DM) + EPS);
        const u32x4* hp = (const u32x4*)(HA + (size_t)m * DM);
        f32x4* op = (f32x4*)(P.out + (size_t)m * DM);
#pragma unroll
        for (int j = 0; j < 2; ++j) { f32x4 v0, v1; unpack8(hp[64 * j + lane], v0, v1);
            const f32x4 w0 = *(const f32x4*)(P.fnw + (64 * j + lane) * 8), w1 = *(const f32x4*)(P.fnw + (64 * j + lane) * 8 + 4);
            op[(64 * j + lane) * 2] = v0 * rs * w0; op[(64 * j + lane) * 2 + 1] = v1 * rs * w1; }
      }
    }
}

extern "C" void kernel_launch(void* const* d_in, const int* in_sizes, int n_in, void* d_out, int out_size, void* d_ws, size_t ws_size, hipStream_t stream) {
    static int grid = 0;
    if (grid == 0) {
        if (n_in != 20 || ws_size < WS_END) { fprintf(stderr, "kernel_launch: unexpected n_in %d or ws_size %zu (need %zu)\n", n_in, ws_size, (size_t)WS_END); grid = -1; return; }
        int dev = 0, cus = 0, per_cu = 0;
        hipGetDevice(&dev); hipDeviceGetAttribute(&cus, hipDeviceAttributeMultiprocessorCount, dev);
        hipFuncSetAttribute((const void*)fwd_kernel, hipFuncAttributeMaxDynamicSharedMemorySize, LDS_BYTES);
        hipOccupancyMaxActiveBlocksPerMultiprocessor(&per_cu, (const void*)fwd_kernel, 512, LDS_BYTES);
        if (per_cu < 1) { fprintf(stderr, "kernel_launch: occupancy query says %d blocks/CU\n", per_cu); per_cu = 1; }
        (void)hipGetLastError();
        grid = cus;
    }
    if (grid < 0) return;
    Params p{};
    p.x = (const float*)d_in[0]; p.meta = (const float*)d_in[1]; p.attn_nw = (const float*)d_in[2]; p.wqkv = (const float*)d_in[3]; p.sinks = (const float*)d_in[4]; p.wo = (const float*)d_in[5];
    p.ssm_nw = (const float*)d_in[6]; p.lre = (const float*)d_in[7]; p.lim = (const float*)d_in[8]; p.logdt = (const float*)d_in[9]; p.bre = (const float*)d_in[10]; p.bim = (const float*)d_in[11];
    p.cre = (const float*)d_in[12]; p.cim = (const float*)d_in[13]; p.dsk = (const float*)d_in[14]; p.wglu = (const float*)d_in[15]; p.mlp_nw = (const float*)d_in[16]; p.wup = (const float*)d_in[17];
    p.wdn = (const float*)d_in[18]; p.fnw = (const float*)d_in[19]; p.out = (float*)d_out; p.ws = (unsigned char*)d_ws;
    void* args[] = {&p};
    hipError_t e = hipLaunchCooperativeKernel((const void*)fwd_kernel, dim3(grid), dim3(512), args, LDS_BYTES, stream);
    if (e != hipSuccess) fprintf(stderr, "cooperative launch failed: %s (grid %d)\n", hipGetErrorString(e), grid);
}
```

```cpp
#include <hip/hip_runtime.h>
#include <hip/hip_cooperative_groups.h>
#include <cstdio>
#include <cstdint>
namespace cg = cooperative_groups;

#define LAS __attribute__((address_space(3)))
typedef unsigned short bf16_t;
typedef short bf16x8 __attribute__((ext_vector_type(8)));
typedef float f32x4 __attribute__((ext_vector_type(4)));
typedef float f32x16 __attribute__((ext_vector_type(16)));
typedef unsigned u32x4 __attribute__((ext_vector_type(4)));
typedef unsigned u32x2 __attribute__((ext_vector_type(2)));
typedef float f32x2_t __attribute__((ext_vector_type(2)));
typedef __bf16 bf16x2_t __attribute__((ext_vector_type(2)));

__device__ __forceinline__ unsigned cvtpk(float lo, float hi) { f32x2_t v = {lo, hi}; bf16x2_t b = __builtin_convertvector(v, bf16x2_t); return __builtin_bit_cast(unsigned, b); }
__device__ __forceinline__ float bflo(unsigned w) { return __uint_as_float(w << 16); }
__device__ __forceinline__ float bfhi(unsigned w) { return __uint_as_float(w & 0xffff0000u); }

__device__ __forceinline__ int fresh_tid(int wave) { int l; asm volatile("v_mbcnt_lo_u32_b32 %0, -1, 0\n\tv_mbcnt_hi_u32_b32 %0, -1, %0" : "=v"(l)); return wave * 64 + l; }
template <int X> __device__ __forceinline__ float xshfl(float v) {
    if (X == 32) { auto rr = __builtin_amdgcn_permlane32_swap(__float_as_uint(v), __float_as_uint(v), false, false);
        const int l = __builtin_amdgcn_mbcnt_lo(~0u, 0u); (void)l; return 0.f; }
    return __uint_as_float((unsigned)__builtin_amdgcn_ds_swizzle((int)__float_as_uint(v), (X << 10) | 0x1f));
}
__device__ __forceinline__ float sum32(float v) { auto rr = __builtin_amdgcn_permlane32_swap(__float_as_uint(v), __float_as_uint(v), false, false); return __uint_as_float(rr[0]) + __uint_as_float(rr[1]); }
__device__ __forceinline__ float max32(float v) { auto rr = __builtin_amdgcn_permlane32_swap(__float_as_uint(v), __float_as_uint(v), false, false); return fmaxf(__uint_as_float(rr[0]), __uint_as_float(rr[1])); }

constexpr int DM = 1024, NB = 16, SEQ = 4096, NMETA = 16, FF = 4096;
constexpr int MREAL = NB * SEQ;
constexpr int MALL = MREAL + 256;
constexpr int NQKV = 1536;
constexpr float EPS = 1e-6f;
constexpr float LOG2E = 1.4426950408889634f;
constexpr int NCH = MREAL / 16;
constexpr int UXLD = 384;

constexpr size_t MiB = 1u << 20;
constexpr size_t WS_WQKV = 0, WS_WO = 3 * MiB, WS_WUP0 = 5 * MiB, WS_WDN0 = 13 * MiB, WS_WGLU = 21 * MiB, WS_WUP1 = 25 * MiB, WS_WDN1 = 33 * MiB;
constexpr size_t WS_BW1 = 41 * MiB, WS_BW2 = 49 * MiB, WS_A16 = 61 * MiB, WS_UM = 61 * MiB + 65536, WS_RS0 = 62 * MiB;
constexpr size_t WS_SS1 = 63 * MiB, WS_SS3 = 68 * MiB, WS_SS4 = 76 * MiB;
constexpr size_t WS_CTL = 81 * MiB;
constexpr size_t WS_RA = 82 * MiB, WS_RB = 211 * MiB, WS_RC = 340 * MiB;
constexpr size_t WS_Q = WS_RC, WS_K = WS_RC + 129 * MiB, WS_V = WS_RC + 162 * MiB;
constexpr size_t WS_ACT = WS_RC;
constexpr size_t WS_UX = WS_RC, WS_S = WS_RC + 192 * MiB, WS_Y = WS_RC + 320 * MiB;
constexpr size_t WS_END = WS_RC + 514 * MiB;

namespace pg8 {
constexpr int BM = 256, BK = 64, HALF = 128, HTB = HALF * BK * 2, STAGE_BYTES = 8 * HTB, NXCD = 8, WGM = 8;
__host__ __device__ __forceinline__ int lds_byte(int r, int c) { const int st = (r >> 4) * 2 + (c >> 5), rr = r & 15, cc = c & 31, ob = rr * 64 + cc * 2; return st * 1024 + (ob ^ (((ob >> 9) & 1) << 5)); }
__host__ __device__ __forceinline__ void stage_rc(int b, int& R, int& C) { const int st = b / 1024, sb = b % 1024, swz = sb ^ (((sb >> 9) & 1) << 5); R = (st >> 1) * 16 + swz / 64; C = (st & 1) * 32 + (swz % 64) / 2; }
__host__ __device__ __forceinline__ int perm32(int rho) { const int n = rho >> 4, i = rho & 15; return 8 * (i >> 2) + 4 * n + (i & 3); }

struct Unit { int pm, pn, pb; };
struct Gemm { const bf16_t* A; const bf16_t* Bt; int K, lda, ldb; size_t bsA, bsB; };

struct StaticOrder {
    int nM, nN, nwg, G, c;
    __device__ void init(int M, int N, int G_, int c_) { nM = M / BM; nN = N / BM; nwg = nM * nN; G = G_; c = c_; }
    __device__ bool next(int i, Unit& u) const {
        const long L = (long)i * G + c; if (L >= nwg) return false;
        int wgid = (int)L; { const int q = nwg / NXCD, r = nwg % NXCD, xcd = wgid % NXCD, off = wgid / NXCD; wgid = (xcd < r ? xcd * (q + 1) : r * (q + 1) + (xcd - r) * q) + off; }
        const int nig = WGM * nN, gid = wgid / nig, fm = gid * WGM, gsz = (nM - fm) < WGM ? (nM - fm) : WGM;
        u.pm = fm + ((wgid % nig) % gsz); u.pn = (wgid % nig) / gsz; u.pb = 0; return true;
    }
};
struct BatchOrder {
    int G, c;
    __device__ bool next(int i, Unit& u) const { const int L = i * G + c; if (L >= 64 * 16) return false; u.pb = L >> 4; u.pm = L & 15; u.pn = 0; return true; }
};

template <class Epi, class Sched>
__device__ __forceinline__ void gemm_phase(LAS unsigned char* lds, const Gemm g, const Sched& S, const Epi& E, int wave_) {
    const int tid_ = fresh_tid(wave_);
    const int tid = tid_, wid = wave_, lane = tid & 63, wr = wid >> 2, wc = wid & 3, fr = lane & 15, fq = lane >> 4;
    const int K = g.K, nt = K / BK;
    unsigned voffA[2], voffB[2];
#pragma unroll
    for (int i = 0; i < 2; ++i) { int R, C; stage_rc(tid * 16 + i * 8192, R, C); const int Rb = (R & ~31) + perm32(R & 31);
        voffA[i] = (unsigned)(R * g.lda + C) * 2u; voffB[i] = (unsigned)(Rb * g.ldb + C) * 2u; }
    const size_t kstep = (size_t)(BK * 2);
    const size_t hA = (size_t)HALF * g.lda * 2, hB = (size_t)HALF * g.ldb * 2;
    const size_t tA = 2 * hA, tB = 2 * hB;
    const unsigned ldsw = (unsigned)wid * 1024u;
    const int aoff = lds_byte(wr * 64 + fr, fq * 8), boff = lds_byte(wc * 32 + fr, fq * 8);
#define PG8_SA(b, h) (((b) * 2 + (h)) * HTB)
#define PG8_SB(b, h) ((4 + (b) * 2 + (h)) * HTB)
#define PG8_STAGE(bufoff, gbase, voff) do { _Pragma("unroll") for (int _i = 0; _i < 2; ++_i) \
        __builtin_amdgcn_global_load_lds((const unsigned*)((const char*)(gbase) + (voff)[_i]), (LAS unsigned*)(lds + (bufoff) + ldsw + _i * 8192), 16, 0, 0); } while (0)
#define PG8_LDA(dst, b, h) do { _Pragma("unroll") for (int m = 0; m < 4; ++m) _Pragma("unroll") for (int k = 0; k < 2; ++k) dst[m][k] = *(const LAS bf16x8*)(lds + PG8_SA(b, h) + aoff + m * 2048 + k * 1024); } while (0)
#define PG8_LDB(dst, b, h) do { _Pragma("unroll") for (int n = 0; n < 2; ++n) _Pragma("unroll") for (int k = 0; k < 2; ++k) dst[n][k] = *(const LAS bf16x8*)(lds + PG8_SB(b, h) + boff + n * 2048 + k * 1024); } while (0)
#define PG8_MMA(ai, bj, At, Bt) do { __builtin_amdgcn_s_setprio(1); _Pragma("unroll") for (int m = 0; m < 4; ++m) _Pragma("unroll") for (int n = 0; n < 2; ++n) _Pragma("unroll") for (int k = 0; k < 2; ++k) \
        acc[ai][bj][m][n] = __builtin_amdgcn_mfma_f32_16x16x32_bf16(Bt[n][k], At[m][k], acc[ai][bj][m][n], 0, 0, 0); __builtin_amdgcn_s_setprio(0); } while (0)
#define PG8_WAIT_V(n) asm volatile("s_waitcnt vmcnt(" #n ")" ::: "memory")
#define PG8_WAIT_L(n) asm volatile("s_waitcnt lgkmcnt(" #n ")" ::: "memory")
#define PG8_BAR __builtin_amdgcn_s_barrier()
#define PG8_SCHED __builtin_amdgcn_sched_barrier(0)
    Unit cur, nxt; int ui = 0;
    if (!S.next(0, cur)) return;
    f32x4 acc[2][2][4][2];
#pragma unroll
    for (int a = 0; a < 2; ++a)
#pragma unroll
        for (int b = 0; b < 2; ++b)
#pragma unroll
            for (int m = 0; m < 4; ++m)
#pragma unroll
                for (int n = 0; n < 2; ++n) acc[a][b][m][n] = (f32x4){0.f, 0.f, 0.f, 0.f};
    bf16x8 At[4][2], B0[2][2], B1[2][2];
    const char* cA = (const char*)g.A + (size_t)cur.pb * g.bsA * 2 + (size_t)cur.pm * tA;
    const char* cB = (const char*)g.Bt + (size_t)cur.pb * g.bsB * 2 + (size_t)cur.pn * tB;
    PG8_STAGE(PG8_SB(0, 0), cB, voffB); PG8_STAGE(PG8_SB(0, 1), cB + hB, voffB); PG8_STAGE(PG8_SA(0, 0), cA, voffA); PG8_STAGE(PG8_SA(0, 1), cA + hA, voffA);
    if (wr == 1) PG8_BAR;
    PG8_WAIT_V(2); PG8_BAR;
    PG8_STAGE(PG8_SB(1, 0), cB + kstep, voffB); PG8_STAGE(PG8_SA(1, 0), cA + kstep, voffA); PG8_STAGE(PG8_SB(1, 1), cB + hB + kstep, voffB);
    PG8_WAIT_V(6); PG8_BAR;
    for (;;) {
        const bool has_next = S.next(ui + 1, nxt);
        const char* nA = has_next ? (const char*)g.A + (size_t)nxt.pb * g.bsA * 2 + (size_t)nxt.pm * tA : cA;
        const char* nB = has_next ? (const char*)g.Bt + (size_t)nxt.pb * g.bsB * 2 + (size_t)nxt.pn * tB : cB;
#pragma unroll 1
        for (int t = 0; t < nt; t += 2) {
            const bool last = (t == nt - 2);
            const char* a1 = cA + (size_t)(t + 1) * kstep;
            const char* a2 = last ? nA : cA + (size_t)(t + 2) * kstep; const char* b2 = last ? nB : cB + (size_t)(t + 2) * kstep;
            const char* a3 = a2 + kstep; const char* b3 = b2 + kstep;
            PG8_LDB(B0, 0, 0); PG8_LDB(B1, 0, 1); PG8_SCHED; PG8_LDA(At, 0, 0); PG8_STAGE(PG8_SA(1, 1), a1 + hA, voffA);
            PG8_WAIT_V(8); PG8_WAIT_L(0); PG8_BAR; PG8_MMA(0, 0, At, B0); PG8_MMA(0, 1, At, B1); PG8_BAR; PG8_SCHED;
            PG8_LDA(At, 0, 1); PG8_STAGE(PG8_SB(0, 0), b2, voffB); PG8_STAGE(PG8_SB(0, 1), b2 + hB, voffB); PG8_STAGE(PG8_SA(0, 0), a2, voffA);
            PG8_WAIT_V(8); PG8_WAIT_L(0); PG8_BAR; PG8_MMA(1, 0, At, B0); PG8_MMA(1, 1, At, B1); PG8_BAR; PG8_SCHED;
            PG8_LDB(B0, 1, 0); PG8_LDB(B1, 1, 1); PG8_SCHED; PG8_LDA(At, 1, 0); PG8_STAGE(PG8_SA(0, 1), a2 + hA, voffA);
            PG8_WAIT_V(8); PG8_WAIT_L(0); PG8_BAR; PG8_MMA(0, 0, At, B0); PG8_MMA(0, 1, At, B1); PG8_BAR; PG8_SCHED;
            PG8_LDA(At, 1, 1); PG8_STAGE(PG8_SB(1, 0), b3, voffB); PG8_STAGE(PG8_SB(1, 1), b3 + hB, voffB); PG8_STAGE(PG8_SA(1, 0), a3, voffA);
            PG8_WAIT_V(8); PG8_WAIT_L(0); PG8_BAR; PG8_MMA(1, 0, At, B0); PG8_MMA(1, 1, At, B1); PG8_BAR; PG8_SCHED;
        }
        if (wr == 0) PG8_BAR;
        E(acc, cur, wr, wc, fr, fq);
        if (!has_next) break;
#pragma unroll
        for (int a = 0; a < 2; ++a)
#pragma unroll
            for (int b = 0; b < 2; ++b)
#pragma unroll
                for (int m = 0; m < 4; ++m)
#pragma unroll
                    for (int n = 0; n < 2; ++n) acc[a][b][m][n] = (f32x4){0.f, 0.f, 0.f, 0.f};
        cur = nxt; cA = nA; cB = nB; ++ui;
        if (wr == 1) PG8_BAR;
    }
    PG8_WAIT_V(0);
    PG8_BAR;
#undef PG8_SA
#undef PG8_SB
#undef PG8_STAGE
#undef PG8_LDA
#undef PG8_LDB
#undef PG8_MMA
#undef PG8_WAIT_V
#undef PG8_WAIT_L
#undef PG8_BAR
#undef PG8_SCHED
}
}
using pg8::Unit;
typedef f32x4 AccT[2][2][4][2];
__device__ __forceinline__ float wave_sum(float v) {
    v += xshfl<1>(v); v += xshfl<2>(v); v += xshfl<4>(v); v += xshfl<8>(v); v += xshfl<16>(v); return sum32(v);
}


__device__ __forceinline__ u32x4 pack8(f32x4 v0, f32x4 v1) { u32x4 w; w.x = cvtpk(v0[0], v0[1]); w.y = cvtpk(v0[2], v0[3]); w.z = cvtpk(v1[0], v1[1]); w.w = cvtpk(v1[2], v1[3]); return w; }
__device__ __forceinline__ void unpack8(u32x4 w, f32x4& v0, f32x4& v1) { v0 = (f32x4){bflo(w.x), bfhi(w.x), bflo(w.y), bfhi(w.y)}; v1 = (f32x4){bflo(w.z), bfhi(w.z), bflo(w.w), bfhi(w.w)}; }

template <int NS> __device__ __forceinline__ float row_rs(const float* SS, int r, int fq) {
    float s;
    if (NS == 16) { const f32x4 a = *(const f32x4*)(SS + (size_t)r * 16 + fq * 4); s = (a[0] + a[1]) + (a[2] + a[3]); }
    else { const f32x4 a = *(const f32x4*)(SS + (size_t)r * 32 + fq * 8), b = *(const f32x4*)(SS + (size_t)r * 32 + fq * 8 + 4); s = ((a[0] + a[1]) + (a[2] + a[3])) + ((b[0] + b[1]) + (b[2] + b[3])); }
    s += xshfl<16>(s); s = sum32(s);
    return __builtin_amdgcn_rsqf(s * (1.0f / DM) + EPS);
}

struct EpiQKV {
    bf16_t* Q; bf16_t* Kb; bf16_t* Vb; const float* rs; float qscale;
    __device__ __forceinline__ void operator()(const AccT& acc, const Unit& u, int wr, int wc, int fr, int fq) const {
        const int row0 = u.pm * 256 + wr * 64 + fr;
        bf16_t* base; int ld, cb; float sc;
        if (u.pn < 4) { base = Q; ld = DM; cb = u.pn * 256; sc = qscale; } else if (u.pn == 4) { base = Kb; ld = 256; cb = 0; sc = 1.f; } else { base = Vb; ld = 256; cb = 0; sc = 1.f; }
        const int col0 = cb + wc * 32 + 8 * fq;
#pragma unroll
        for (int ai = 0; ai < 2; ++ai)
#pragma unroll
            for (int m = 0; m < 4; ++m) { const int r = row0 + ai * 128 + m * 16; const float s = rs[r] * sc; bf16_t* rowp = base + (size_t)r * ld + col0;
#pragma unroll
                for (int bj = 0; bj < 2; ++bj) *(u32x4*)(rowp + bj * 128) = pack8(acc[ai][bj][m][0] * s, acc[ai][bj][m][1] * s); }
    }
};
struct EpiResid {
    const bf16_t* Hin; bf16_t* Hout; float* SS;
    __device__ __forceinline__ void operator()(const AccT& acc, const Unit& u, int wr, int wc, int fr, int fq) const {
        const int row0 = u.pm * 256 + wr * 64 + fr, col0 = u.pn * 256 + wc * 32 + 8 * fq;
#pragma unroll
        for (int ai = 0; ai < 2; ++ai)
#pragma unroll
            for (int m = 0; m < 4; ++m) { const int r = row0 + ai * 128 + m * 16; const size_t off = (size_t)r * DM + col0; float q = 0.f;
#pragma unroll
                for (int bj = 0; bj < 2; ++bj) { f32x4 h0, h1; unpack8(*(const u32x4*)(Hin + off + bj * 128), h0, h1);
                    const f32x4 v0 = acc[ai][bj][m][0] + h0, v1 = acc[ai][bj][m][1] + h1;
                    q += (v0[0] * v0[0] + v0[1] * v0[1]) + (v0[2] * v0[2] + v0[3] * v0[3]) + (v1[0] * v1[0] + v1[1] * v1[1]) + (v1[2] * v1[2] + v1[3] * v1[3]);
                    *(u32x4*)(Hout + off + bj * 128) = pack8(v0, v1); }
                if (SS) { q += xshfl<16>(q); q = sum32(q); if (fq == 0) SS[(size_t)r * 16 + u.pn * 4 + wc] = q; } }
    }
};
template <int NS> struct EpiUp {
    const float* SS; bf16_t* ACT;
    __device__ __forceinline__ void operator()(const AccT& acc, const Unit& u, int wr, int wc, int fr, int fq) const {
        const int row0 = u.pm * 256 + wr * 64 + fr, col0 = u.pn * 256 + wc * 32 + 8 * fq;
#pragma unroll
        for (int ai = 0; ai < 2; ++ai)
#pragma unroll
            for (int m = 0; m < 4; ++m) { const int r = row0 + ai * 128 + m * 16; const float s = row_rs<NS>(SS, r, fq); bf16_t* rowp = ACT + (size_t)r * FF + col0;
#pragma unroll
                for (int bj = 0; bj < 2; ++bj) { f32x4 v0 = acc[ai][bj][m][0] * s, v1 = acc[ai][bj][m][1] * s;
#pragma unroll
                    for (int i = 0; i < 4; ++i) { const float a = fmaxf(v0[i], 0.f), b = fmaxf(v1[i], 0.f); v0[i] = a * a; v1[i] = b * b; }
                    *(u32x4*)(rowp + bj * 128) = pack8(v0, v1); } }
    }
};
struct EpiS {
    float* S;
    __device__ __forceinline__ void operator()(const AccT& acc, const Unit& u, int wr, int wc, int fr, int fq) const {
        const int row0 = u.pm * 256 + wr * 64 + fr, col0 = wc * 32 + 8 * fq;
#pragma unroll
        for (int ai = 0; ai < 2; ++ai)
#pragma unroll
            for (int m = 0; m < 4; ++m) { const int r = row0 + ai * 128 + m * 16; float* p = S + ((size_t)u.pb * NCH + r) * 128 + col0;
                *(f32x4*)p = acc[ai][0][m][0]; *(f32x4*)(p + 4) = acc[ai][0][m][1]; }
    }
};
__device__ __forceinline__ float gelu_tanh(float x) { const float z = 0.7978845608028654f * (x + 0.044715f * x * x * x); return x * __builtin_amdgcn_rcpf(1.0f + __builtin_amdgcn_exp2f(-2.0f * LOG2E * z)); }
struct EpiY {
    const bf16_t* UX; const float* Dsk; bf16_t* Y;
    __device__ __forceinline__ void operator()(const AccT& acc, const Unit& u, int wr, int wc, int fr, int fq) const {
        const int g = u.pb; const int r0 = u.pm * 256 + wr * 64 + fr; const int colb = wc * 32 + 8 * fq, c0 = colb & 15;
        const f32x4 d0 = *(const f32x4*)(Dsk + g * 16 + c0), d1 = *(const f32x4*)(Dsk + g * 16 + c0 + 4);
        unsigned offU = (unsigned)(((size_t)g * NCH + r0) * UXLD + colb) * 2u;
        unsigned offY = (unsigned)(((size_t)r0 * 16 + (colb >> 4)) * DM + g * 16 + c0) * 2u;
#pragma unroll
        for (int ai = 0; ai < 2; ++ai)
#pragma unroll
            for (int m = 0; m < 4; ++m) {
                asm volatile("" : "+v"(offU), "+v"(offY));
#pragma unroll
                for (int bj = 0; bj < 2; ++bj) {
                    const u32x4 uw = *(const u32x4*)((const char*)UX + offU + bj * 256); u32x4 ow;
                    { f32x4 v = acc[ai][bj][m][0] + d0 * (f32x4){bflo(uw.x), bfhi(uw.x), bflo(uw.y), bfhi(uw.y)};
#pragma unroll
                      for (int i = 0; i < 4; ++i) v[i] = gelu_tanh(v[i]);
                      ow.x = cvtpk(v[0], v[1]); ow.y = cvtpk(v[2], v[3]); asm volatile("" : "+v"(ow.x), "+v"(ow.y)); }
                    { f32x4 v = acc[ai][bj][m][1] + d1 * (f32x4){bflo(uw.z), bfhi(uw.z), bflo(uw.w), bfhi(uw.w)};
#pragma unroll
                      for (int i = 0; i < 4; ++i) v[i] = gelu_tanh(v[i]);
                      ow.z = cvtpk(v[0], v[1]); ow.w = cvtpk(v[2], v[3]); }
                    *(u32x4*)((char*)Y + offY + bj * (8 * DM * 2)) = ow; asm volatile("" ::: "memory"); }
                offU += (m == 3 ? 80 : 16) * UXLD * 2; offY += (m == 3 ? 80 : 16) * 16 * DM * 2;
            }
    }
};
struct EpiGLU {
    const bf16_t* Hin; bf16_t* Hout; float* SS;
    __device__ __forceinline__ void operator()(const AccT& acc, const Unit& u, int wr, int wc, int fr, int fq) const {
        const int row0 = u.pm * 256 + wr * 64 + fr, col0 = u.pn * 128 + wc * 32 + 8 * fq;
#pragma unroll
        for (int ai = 0; ai < 2; ++ai)
#pragma unroll
            for (int m = 0; m < 4; ++m) { const int r = row0 + ai * 128 + m * 16; const size_t off = (size_t)r * DM + col0;
                f32x4 h0, h1; unpack8(*(const u32x4*)(Hin + off), h0, h1);
                f32x4 v0, v1;
#pragma unroll
                for (int i = 0; i < 4; ++i) {
                    v0[i] = h0[i] + acc[ai][0][m][0][i] * __builtin_amdgcn_rcpf(1.0f + __builtin_amdgcn_exp2f(-LOG2E * acc[ai][1][m][0][i]));
                    v1[i] = h1[i] + acc[ai][0][m][1][i] * __builtin_amdgcn_rcpf(1.0f + __builtin_amdgcn_exp2f(-LOG2E * acc[ai][1][m][1][i])); }
                float q = (v0[0] * v0[0] + v0[1] * v0[1]) + (v0[2] * v0[2] + v0[3] * v0[3]) + (v1[0] * v1[0] + v1[1] * v1[1]) + (v1[2] * v1[2] + v1[3] * v1[3]);
                *(u32x4*)(Hout + off) = pack8(v0, v1);
                q += xshfl<16>(q); q = sum32(q); if (fq == 0) SS[(size_t)r * 32 + u.pn * 4 + wc] = q; }
    }
};

struct Params {
    const float* x; const float* meta; const float* attn_nw; const float* wqkv; const float* sinks; const float* wo;
    const float* ssm_nw; const float* lre; const float* lim; const float* logdt; const float* bre; const float* bim; const float* cre; const float* cim; const float* dsk; const float* wglu;
    const float* mlp_nw; const float* wup; const float* wdn; const float* fnw;
    float* out; unsigned char* ws;
};


__device__ __forceinline__ void transpose_item(const float* W, int K, int N, bf16_t* WT, const float* kscale, bool glu, LAS float* scr, int item, int lane) {
    const int nblk = N / 32, kb = item / nblk, nb = item % nblk, k0 = 64 * kb, n0 = 32 * nb;
#pragma unroll 8
    for (int i = 0; i < 32; ++i) { const int kk = 2 * i + (lane >> 5); float v = W[(size_t)(k0 + kk) * N + n0 + (lane & 31)]; if (kscale) v *= kscale[k0 + kk]; scr[kk * 33 + (lane & 31)] = v; }
    asm volatile("s_waitcnt lgkmcnt(0)" ::: "memory");
    const int c = lane & 7;
#pragma unroll
    for (int j = 0; j < 4; ++j) { const int n = (lane >> 3) + 8 * j; const LAS float* s = scr + (8 * c) * 33 + n;
        u32x4 o; o.x = cvtpk(s[0 * 33], s[1 * 33]); o.y = cvtpk(s[2 * 33], s[3 * 33]); o.z = cvtpk(s[4 * 33], s[5 * 33]); o.w = cvtpk(s[6 * 33], s[7 * 33]);
        int nd = n0 + n; if (glu) { const int bj = nd >> 10, rem = nd & 1023; nd = (rem >> 7) * 256 + bj * 128 + (rem & 127); }
        *(u32x4*)(WT + (size_t)nd * K + k0 + 8 * c) = o; }
    asm volatile("s_waitcnt lgkmcnt(0)" ::: "memory");
}

struct SsmP { float lr, li, dt; };
__device__ __forceinline__ void cpow(const SsmP& s, float tau, float& re, float& im) { const float mag = expf(s.lr * s.dt * tau); float sn, cs; sincosf(s.li * s.dt * tau, &sn, &cs); re = mag * cs; im = mag * sn; }
__device__ __forceinline__ void ccoef(const SsmP& s, float& re, float& im) {
    float ar, ai; cpow(s, 1.0f, ar, ai); ar -= 1.0f; const float den = 1.0f / (s.lr * s.lr + s.li * s.li);
    re = (ar * s.lr + ai * s.li) * den; im = (ai * s.lr - ar * s.li) * den;
}

template <int MODE> __device__ __forceinline__ void meta_gemm(const bf16_t* A, int lda, const bf16_t* Wt, int N, int K, int gw, int NGW, int lane,
                                                              const float* rs0, bf16_t* o0, bf16_t* o1, bf16_t* o2, const bf16_t* hin) {
    float rsv = 1.0f;
    if (MODE == 2) {
        for (int r = 0; r < 16; ++r) { f32x4 v0, v1, v2, v3; const u32x4* hp = (const u32x4*)(A + (size_t)r * lda + lane * 16); unpack8(hp[0], v0, v1); unpack8(hp[1], v2, v3);
            float s = (v0[0] * v0[0] + v0[1] * v0[1]) + (v0[2] * v0[2] + v0[3] * v0[3]) + (v1[0] * v1[0] + v1[1] * v1[1]) + (v1[2] * v1[2] + v1[3] * v1[3])
                    + (v2[0] * v2[0] + v2[1] * v2[1]) + (v2[2] * v2[2] + v2[3] * v2[3]) + (v3[0] * v3[0] + v3[1] * v3[1]) + (v3[2] * v3[2] + v3[3] * v3[3]);
            s = wave_sum(s); if (lane == r) rsv = 1.0f / sqrtf(s * (1.0f / DM) + EPS); }
    }
    for (int n = gw; n < N; n += NGW) {
        float acc[16];
#pragma unroll
        for (int r = 0; r < 16; ++r) acc[r] = 0.f;
        for (int k0 = lane * 8; k0 < K; k0 += 512) {
            f32x4 w0, w1; unpack8(*(const u32x4*)(Wt + (size_t)n * K + k0), w0, w1);
#pragma unroll
            for (int r = 0; r < 16; ++r) { f32x4 a0, a1; unpack8(*(const u32x4*)(A + (size_t)r * lda + k0), a0, a1);
                acc[r] += (a0[0] * w0[0] + a0[1] * w0[1]) + (a0[2] * w0[2] + a0[3] * w0[3]) + (a1[0] * w1[0] + a1[1] * w1[1]) + (a1[2] * w1[2] + a1[3] * w1[3]); }
        }
        float v = 0.f;
#pragma unroll
        for (int r = 0; r < 16; ++r) { const float s = wave_sum(acc[r]); v = (lane == r) ? s : v; }
        if (lane < 16) { const size_t row = MREAL + lane;
            if (MODE == 0) { v *= rs0[row]; bf16_t* dst; if (n < 1024) { v *= 0.125f * LOG2E; dst = o0 + row * DM + n; } else if (n < 1280) dst = o1 + row * 256 + (n - 1024); else dst = o2 + row * 256 + (n - 1280);
                *dst = (bf16_t)(cvtpk(v, 0.f) & 0xffffu); }
            else if (MODE == 1 || MODE == 3) { v += bflo((unsigned)hin[row * DM + n]); o0[row * DM + n] = (bf16_t)(cvtpk(v, 0.f) & 0xffffu); }
            else { v = fmaxf(v * rsv, 0.f); v = v * v; o0[row * FF + n] = (bf16_t)(cvtpk(v, 0.f) & 0xffffu); }
        }
    }
}

constexpr int KS_LD = 72, VT_LD = 296, KS_BYTES = 288 * KS_LD * 2;
__device__ __forceinline__ void attn_phase(LAS unsigned char* lds, bf16_t* Q, const bf16_t* Kb, const bf16_t* Vb, const float* sinks, int vcu, int G, int wave_) {
    const int tid_ = fresh_tid(wave_);
    const int tid = tid_, lane = tid & 63, wid = wave_, q = lane & 31, hi = lane >> 5;
    LAS bf16_t* Ks = (LAS bf16_t*)lds; LAS bf16_t* Vt = (LAS bf16_t*)(lds + KS_BYTES);
    const int piq = (q & 0x13) | ((q & 4) << 1) | ((q & 8) >> 1);
#pragma unroll 1
    for (int L = vcu; L < 2052; L += G) {
        const bool meta = L >= 2048;
        int b = 0, kvh, qb = 0;
        if (!meta) { b = L >> 7; kvh = (L >> 5) & 3; qb = L & 31; } else kvh = L - 2048;
        const int t0 = qb * 128;
        __syncthreads();
        for (int i = tid; i < 288 * 8; i += 512) {
            const int kk = i >> 3, ch = i & 7; long row = -1;
            if (kk < 256) { const int s = t0 - 128 + kk; if (!meta && s >= 0) row = (long)b * SEQ + s; } else if (kk < 272) row = MREAL + (kk - 256);
            u32x4 kv = (u32x4){0u, 0u, 0u, 0u}, vv = (u32x4){0u, 0u, 0u, 0u};
            if (row >= 0) { kv = *(const u32x4*)(Kb + row * 256 + kvh * 64 + ch * 8); vv = *(const u32x4*)(Vb + row * 256 + kvh * 64 + ch * 8); }
            *(LAS u32x4*)(Ks + kk * KS_LD + ch * 8) = kv;
            LAS bf16_t* vp = Vt + (ch * 8) * VT_LD + kk;
            vp[0 * VT_LD] = (bf16_t)(vv.x & 0xffffu); vp[1 * VT_LD] = (bf16_t)(vv.x >> 16); vp[2 * VT_LD] = (bf16_t)(vv.y & 0xffffu); vp[3 * VT_LD] = (bf16_t)(vv.y >> 16);
            vp[4 * VT_LD] = (bf16_t)(vv.z & 0xffffu); vp[5 * VT_LD] = (bf16_t)(vv.z >> 16); vp[6 * VT_LD] = (bf16_t)(vv.w & 0xffffu); vp[7 * VT_LD] = (bf16_t)(vv.w >> 16);
        }
        __syncthreads();
        const int hq = kvh * 4 + (wid >> 1);
        const float slope = exp2f(-0.5f * (float)(hq + 1)) * LOG2E, sink = sinks[hq] * LOG2E;
#pragma unroll 1
        for (int it = 0; it < 2; ++it) {
            const int rt = (wid & 1) * 2 + it;
            if (meta && rt != 0) continue;
            const long qrow = meta ? (long)(MREAL + q) : (long)b * SEQ + t0 + 32 * rt + q;
            bf16_t* qp = Q + qrow * DM + hq * 64;
            bf16x8 qf[4];
#pragma unroll
            for (int dk = 0; dk < 4; ++dk) qf[dk] = *(const bf16x8*)(qp + dk * 16 + hi * 8);
            f32x16 S[6];
#pragma unroll
            for (int k6 = 0; k6 < 6; ++k6) { const int kt = (k6 < 5) ? rt + k6 : 8; f32x16 a = {};
                const LAS bf16_t* kp = Ks + (32 * kt + piq) * KS_LD + hi * 8;
#pragma unroll
                for (int dk = 0; dk < 4; ++dk) a = __builtin_amdgcn_mfma_f32_32x32x16_bf16(*(const LAS bf16x8*)(kp + dk * 16), qf[dk], a, 0, 0, 0);
                S[k6] = a; asm volatile("" ::: "memory"); }
            float mx = sink;
            int base = 128 + q - 8 * hi; asm volatile("" : "+v"(base));
            const float fb = (float)base;
            const unsigned lim1 = meta ? 0u : (unsigned)min(128, t0 + 32 * rt + q + 1);
            const int qlim = meta ? q : 15;
#pragma unroll
            for (int k6 = 0; k6 < 6; ++k6)
#pragma unroll
                for (int r = 0; r < 16; ++r) { bool ok; float v;
                    if (k6 < 5) { const int cc = 32 * k6 + (r & 7) + 16 * (r >> 3); const int dist = base - cc; ok = (unsigned)dist < lim1; v = S[k6][r] - slope * (fb - (float)cc); }
                    else { const int kin = (r & 7) + 8 * hi + 16 * (r >> 3); ok = kin <= qlim; v = S[k6][r]; }
                    v = ok ? v : -1e30f; S[k6][r] = v; mx = fmaxf(mx, v); }
            mx = max32(mx);
            float l = 0.f;
#pragma unroll
            for (int k6 = 0; k6 < 6; ++k6)
#pragma unroll
                for (int r = 0; r < 16; ++r) { const float p = __builtin_amdgcn_exp2f(S[k6][r] - mx); S[k6][r] = p; l += p; }
            l = sum32(l); l += __builtin_amdgcn_exp2f(sink - mx);
            f32x16 O[2]; O[0] = f32x16{}; O[1] = f32x16{};
#pragma unroll
            for (int k6 = 0; k6 < 6; ++k6) { const int kt = (k6 < 5) ? rt + k6 : 8;
#pragma unroll
                for (int hf = 0; hf < 2; ++hf) {
                    u32x4 pw; pw.x = cvtpk(S[k6][8 * hf + 0], S[k6][8 * hf + 1]); pw.y = cvtpk(S[k6][8 * hf + 2], S[k6][8 * hf + 3]); pw.z = cvtpk(S[k6][8 * hf + 4], S[k6][8 * hf + 5]); pw.w = cvtpk(S[k6][8 * hf + 6], S[k6][8 * hf + 7]);
                    const bf16x8 pb = __builtin_bit_cast(bf16x8, pw);
#pragma unroll
                    for (int dt = 0; dt < 2; ++dt) { const bf16x8 va = *(const LAS bf16x8*)(Vt + (32 * dt + q) * VT_LD + 32 * kt + 16 * hf + 8 * hi);
                        O[dt] = __builtin_amdgcn_mfma_f32_32x32x16_bf16(va, pb, O[dt], 0, 0, 0); }
                    asm volatile("" ::: "memory"); } }
            const float rl = 1.0f / l;
#pragma unroll
            for (int dt = 0; dt < 2; ++dt)
#pragma unroll
                for (int j = 0; j < 4; ++j) { u32x2 w; w.x = cvtpk(O[dt][4 * j] * rl, O[dt][4 * j + 1] * rl); w.y = cvtpk(O[dt][4 * j + 2] * rl, O[dt][4 * j + 3] * rl);
                    if (!meta || q < 16) *(u32x2*)(qp + 32 * dt + 8 * j + 4 * hi) = w; }
        }
    }
    __syncthreads();
}

#define XB_TMO      128
#define XB_XCNT(j)  (256  + 64 * (j))
#define XB_XSUB(j)  (1280 + 64 * (j))
#define XB_XGEN(j)  (2304 + 64 * (j))
#define XB_TOP      3328
#define XB_TOPGEN   3392
#define XCD_BAR_WORDS 3456
#define XB_SPIN_CAP (1u << 18)
__device__ __forceinline__ unsigned xb_ld(unsigned* p)              { return __hip_atomic_load(p, __ATOMIC_RELAXED, __HIP_MEMORY_SCOPE_AGENT); }
__device__ __forceinline__ unsigned xb_add(unsigned* p, unsigned v) { return __hip_atomic_fetch_add(p, v, __ATOMIC_RELAXED, __HIP_MEMORY_SCOPE_AGENT); }
__device__ __forceinline__ unsigned xb_xcc_id() { return (unsigned)__builtin_amdgcn_s_getreg((3 << 11) | 20) & 0xFu; }
#define XB_SPIN(cond, bar) do { unsigned _sp = 0; while (cond) { __builtin_amdgcn_s_sleep(1); \
    if ((++_sp & 255u) == 0u) { if (xb_ld(&(bar)[XB_TMO])) break; if (_sp > XB_SPIN_CAP) { atomicAdd(&(bar)[XB_TMO], 1u); break; } } } } while (0)
struct XcdBarrier { unsigned* bar; unsigned x; volatile LAS unsigned* st; };
__device__ __forceinline__ XcdBarrier xcd_barrier_post(unsigned* bar, volatile LAS unsigned* st) {
    XcdBarrier b; b.bar = bar; b.x = xb_xcc_id(); b.st = st;
    if (threadIdx.x == 0) (void)xb_add(&bar[XB_XCNT(b.x)], 1u);
    return b;
}
__device__ __forceinline__ void xcd_barrier_complete(unsigned* bar, unsigned x, unsigned& nloc, unsigned& nx) {
    const unsigned G = gridDim.x * gridDim.y * gridDim.z;
    unsigned sum, cnt, mine, sp = 0u;
    for (;;) {
        sum = 0u; cnt = 0u; mine = 0u;
#pragma unroll
        for (unsigned j = 0; j < 16; ++j) { const unsigned c = xb_ld(&bar[XB_XCNT(j)]); sum += c; cnt += (c > 0u) ? 1u : 0u; mine = (j == x) ? c : mine; }
        if (sum == G) break;
        __builtin_amdgcn_s_sleep(1);
        if ((++sp & 255u) == 0u) { if (xb_ld(&bar[XB_TMO])) break; if (sp > XB_SPIN_CAP) { atomicAdd(&bar[XB_TMO], 1u); break; } }
    }
    nloc = mine > 0u ? mine : 1u; nx = cnt > 0u ? cnt : 1u;
}
__device__ __forceinline__ void xcd_barrier(const XcdBarrier& b) {
    asm volatile("s_waitcnt vmcnt(0)" ::: "memory");
    __syncthreads();
    if (threadIdx.x == 0) {
        unsigned* bar = b.bar;
        __builtin_amdgcn_s_waitcnt(0);
        unsigned nloc = b.st[0], nx = b.st[1];
        if (nloc == 0u) { xcd_barrier_complete(bar, b.x, nloc, nx); b.st[0] = nloc; b.st[1] = nx; }
        const unsigned old = xb_add(&bar[XB_XSUB(b.x)], 1u);
        const unsigned gen = old / nloc;
        if (old + 1u == (gen + 1u) * nloc) {
            __builtin_amdgcn_fence(__ATOMIC_RELEASE, "agent");
            asm volatile("s_waitcnt vmcnt(0)" ::: "memory");
            const unsigned og = xb_add(&bar[XB_TOP], 1u);
            const unsigned tg = og / nx;
            if (og + 1u == (tg + 1u) * nx) xb_add(&bar[XB_TOPGEN], 1u);
            else XB_SPIN(xb_ld(&bar[XB_TOPGEN]) == tg, bar);
            __builtin_amdgcn_fence(__ATOMIC_ACQUIRE, "agent");
            xb_add(&bar[XB_XGEN(b.x)], 1u);
            asm volatile("s_waitcnt vmcnt(0)" ::: "memory");
        } else {
            XB_SPIN(xb_ld(&bar[XB_XGEN(b.x)]) == gen, bar);
            __builtin_amdgcn_fence(__ATOMIC_ACQUIRE, "agent");
            asm volatile("s_waitcnt vmcnt(0)" ::: "memory");
        }
    }
    __syncthreads();
}

constexpr int LDS_BYTES = 147456;
#ifndef PHMASK
#define PHMASK 0xFFFF
#endif
#ifndef DUPMASK
#define DUPMASK 0
#endif
#ifndef XSYNC
#define XSYNC 0
#endif
#define REP(k) for (int rep_ = 0; rep_ < ((DUPMASK >> (k)) & 1) + 1; ++rep_)
__global__ void __launch_bounds__(512, 2) fwd_kernel(Params P) {
    extern __shared__ __attribute__((aligned(16))) unsigned char lds_raw[];
    LAS unsigned char* lds = (LAS unsigned char*)lds_raw;
    cg::grid_group grid = cg::this_grid();
    const int wave = __builtin_amdgcn_readfirstlane((int)threadIdx.x >> 6);
    const int G = gridDim.x, bx = blockIdx.x;
    const int vcu = (G % 8 == 0) ? (bx % 8) * (G / 8) + bx / 8 : bx;
    const int gw = vcu * 8 + wave, NGW = G * 8;
    unsigned char* ws = P.ws;
    volatile LAS unsigned* bst = (volatile LAS unsigned*)(lds + 131072);
    if (threadIdx.x < 2) bst[threadIdx.x] = 0u;
    __syncthreads();
    const XcdBarrier xbar = xcd_barrier_post((unsigned*)(ws + WS_CTL), bst);
    bf16_t* Wqkv_t = (bf16_t*)(ws + WS_WQKV); bf16_t* Wo_t = (bf16_t*)(ws + WS_WO); bf16_t* Wup0_t = (bf16_t*)(ws + WS_WUP0); bf16_t* Wdn0_t = (bf16_t*)(ws + WS_WDN0);
    bf16_t* Wglu_t = (bf16_t*)(ws + WS_WGLU); bf16_t* Wup1_t = (bf16_t*)(ws + WS_WUP1); bf16_t* Wdn1_t = (bf16_t*)(ws + WS_WDN1);
    bf16_t* BW1 = (bf16_t*)(ws + WS_BW1); bf16_t* BW2 = (bf16_t*)(ws + WS_BW2); float* A16 = (float*)(ws + WS_A16); bf16_t* UM = (bf16_t*)(ws + WS_UM);
    float* RS0 = (float*)(ws + WS_RS0); float* SS1 = (float*)(ws + WS_SS1); float* SS3 = (float*)(ws + WS_SS3); float* SS4 = (float*)(ws + WS_SS4);
    bf16_t* HA = (bf16_t*)(ws + WS_RA); bf16_t* HB = (bf16_t*)(ws + WS_RB);
    bf16_t* Qb = (bf16_t*)(ws + WS_Q); bf16_t* Kb = (bf16_t*)(ws + WS_K); bf16_t* Vb = (bf16_t*)(ws + WS_V); bf16_t* ACT = (bf16_t*)(ws + WS_ACT);
    bf16_t* UX = (bf16_t*)(ws + WS_UX); float* Sst = (float*)(ws + WS_S); bf16_t* Yb = (bf16_t*)(ws + WS_Y);

    REP(0) if (PHMASK & 1) {
        const int t_ = fresh_tid(wave); const int tid = t_, lane = tid & 63; (void)tid; (void)lane;
        LAS float* scr = (LAS float*)(lds + wave * 16384);
        constexpr int I_QKV = 16 * 48, I_O = 16 * 32, I_UP = 16 * 128, I_DN = 64 * 32, I_GLU = 16 * 64;
        constexpr int NITEMS = I_QKV + I_O + 2 * I_UP + 2 * I_DN + I_GLU;
        for (int it = gw; it < NITEMS; it += NGW) {
            int r = it;
            if (r < I_QKV) { transpose_item(P.wqkv, DM, NQKV, Wqkv_t, P.attn_nw, false, scr, r, lane); continue; } r -= I_QKV;
            if (r < I_O) { transpose_item(P.wo, DM, DM, Wo_t, nullptr, false, scr, r, lane); continue; } r -= I_O;
            if (r < I_UP) { transpose_item(P.wup, DM, FF, Wup0_t, P.mlp_nw, false, scr, r, lane); continue; } r -= I_UP;
            if (r < I_DN) { transpose_item(P.wdn, FF, DM, Wdn0_t, nullptr, false, scr, r, lane); continue; } r -= I_DN;
            if (r < I_GLU) { transpose_item(P.wglu, DM, 2 * DM, Wglu_t, nullptr, true, scr, r, lane); continue; } r -= I_GLU;
            if (r < I_UP) { transpose_item(P.wup + (size_t)DM * FF, DM, FF, Wup1_t, P.mlp_nw + DM, false, scr, r, lane); continue; } r -= I_UP;
            transpose_item(P.wdn + (size_t)FF * DM, FF, DM, Wdn1_t, nullptr, false, scr, r, lane);
        }
        for (int m = gw; m < MREAL + NMETA; m += NGW) {
            unsigned long long* o8 = (unsigned long long*)(HA + (size_t)m * DM) + lane;
            const float* src = (m < MREAL) ? P.x + (size_t)m * DM : P.meta + (size_t)(m - MREAL) * DM;
            const f32x4* xr = (const f32x4*)src + lane; f32x4 v[4]; float s = 0.f;
#pragma unroll
            for (int j = 0; j < 4; ++j) { v[j] = xr[64 * j]; s += (v[j].x * v[j].x + v[j].y * v[j].y) + (v[j].z * v[j].z + v[j].w * v[j].w); }
            s = wave_sum(s);
#pragma unroll
            for (int j = 0; j < 4; ++j) o8[64 * j] = (unsigned long long)cvtpk(v[j].x, v[j].y) | ((unsigned long long)cvtpk(v[j].z, v[j].w) << 32);
            if (lane == 0) RS0[m] = 1.0f / sqrtf(s * (1.0f / DM) + EPS);
        }
        __syncthreads();
        {
            LAS float* AP = (LAS float*)lds;
            LAS float* BB = AP + 17 * 64 * 2;
            LAS float* CC = BB + 64 * 16 * 2;
            LAS float* KT = CC + 16 * 64 * 2;
            for (int item = vcu; item < 256; item += G) {
                const int g = item >> 2, qd = item & 3;
                const float dt = expf(P.logdt[g]);
                for (int idx = tid; idx < 17 * 64; idx += 512) { const int tau = idx >> 6, p = idx & 63;
                    SsmP s; s.lr = fminf(P.lre[g * 64 + p], -1e-4f); s.li = P.lim[g * 64 + p]; s.dt = dt; float ar, ai; cpow(s, (float)tau, ar, ai); AP[idx * 2] = ar; AP[idx * 2 + 1] = ai; }
                for (int idx = tid; idx < 64 * 16; idx += 512) { const int p = idx >> 4;
                    SsmP s; s.lr = fminf(P.lre[g * 64 + p], -1e-4f); s.li = P.lim[g * 64 + p]; s.dt = dt; float cr, ci; ccoef(s, cr, ci);
                    const float br = P.bre[g * 1024 + idx], bi = P.bim[g * 1024 + idx]; BB[idx * 2] = cr * br - ci * bi; BB[idx * 2 + 1] = cr * bi + ci * br; }
                for (int idx = tid; idx < 16 * 64; idx += 512) { CC[idx * 2] = P.cre[g * 1024 + idx]; CC[idx * 2 + 1] = P.cim[g * 1024 + idx]; }
                __syncthreads();
                for (int idx = tid; idx < 4096; idx += 512) { const int tau = idx >> 8, c = (idx >> 4) & 15, cp = idx & 15; float k = 0.f;
                    for (int p = 0; p < 64; ++p) { const float ar = AP[(tau * 64 + p) * 2], ai = AP[(tau * 64 + p) * 2 + 1], br = BB[(p * 16 + cp) * 2], bi = BB[(p * 16 + cp) * 2 + 1];
                        k += CC[(c * 64 + p) * 2] * (ar * br - ai * bi) - CC[(c * 64 + p) * 2 + 1] * (ar * bi + ai * br); }
                    KT[idx] = k; }
                __syncthreads();
                for (int idx = tid; idx < 64 * 32; idx += 512) { const int n = qd * 64 + (idx >> 5), k0 = (idx & 31) * 8, ti = n >> 4, c = n & 15, si = k0 >> 4, cp0 = k0 & 15;
                    u32x4 w = (u32x4){0u, 0u, 0u, 0u};
                    if (si <= ti) { const LAS float* kp = KT + ((ti - si) * 16 + c) * 16 + cp0; w.x = cvtpk(kp[0], kp[1]); w.y = cvtpk(kp[2], kp[3]); w.z = cvtpk(kp[4], kp[5]); w.w = cvtpk(kp[6], kp[7]); }
                    *(u32x4*)(BW2 + ((size_t)g * 256 + n) * UXLD + k0) = w; }
                for (int idx = tid; idx < 64 * 16; idx += 512) { const int n = qd * 64 + (idx >> 4), p0 = (idx & 15) * 4, ti = n >> 4, c = n & 15; unsigned w[4];
#pragma unroll
                    for (int j = 0; j < 4; ++j) { const int p = p0 + j; const float cr = CC[(c * 64 + p) * 2], ci = CC[(c * 64 + p) * 2 + 1], ar = AP[((ti + 1) * 64 + p) * 2], ai = AP[((ti + 1) * 64 + p) * 2 + 1];
                        w[j] = cvtpk(cr * ar - ci * ai, -(cr * ai + ci * ar)); }
                    *(u32x4*)(BW2 + ((size_t)g * 256 + n) * UXLD + 256 + 2 * p0) = (u32x4){w[0], w[1], w[2], w[3]}; }
                for (int idx = tid; idx < 16 * 32; idx += 512) { const int p = qd * 16 + (idx >> 5), k0 = (idx & 31) * 8, si = k0 >> 4, cp0 = k0 & 15;
                    const float ar = AP[((15 - si) * 64 + p) * 2], ai = AP[((15 - si) * 64 + p) * 2 + 1]; float re[8], im[8];
#pragma unroll
                    for (int j = 0; j < 8; ++j) { const float br = BB[(p * 16 + cp0 + j) * 2], bi = BB[(p * 16 + cp0 + j) * 2 + 1]; re[j] = ar * br - ai * bi; im[j] = ar * bi + ai * br; }
                    *(u32x4*)(BW1 + ((size_t)g * 256 + 2 * p) * 256 + k0) = (u32x4){cvtpk(re[0], re[1]), cvtpk(re[2], re[3]), cvtpk(re[4], re[5]), cvtpk(re[6], re[7])};
                    *(u32x4*)(BW1 + ((size_t)g * 256 + 2 * p + 1) * 256 + k0) = (u32x4){cvtpk(im[0], im[1]), cvtpk(im[2], im[3]), cvtpk(im[4], im[5]), cvtpk(im[6], im[7])}; }
                for (int idx = tid; idx < 32 * 32; idx += 512) { const int n = 128 + qd * 32 + (idx >> 5), k0 = (idx & 31) * 8;
                    *(u32x4*)(BW1 + ((size_t)g * 256 + n) * 256 + k0) = (u32x4){0u, 0u, 0u, 0u}; }
                if (qd == 0 && tid < 64) { A16[2 * (g * 64 + tid)] = AP[(16 * 64 + tid) * 2]; A16[2 * (g * 64 + tid) + 1] = AP[(16 * 64 + tid) * 2 + 1]; }
                __syncthreads();
            }
        }
    }
    grid.sync();

    REP(1) if (PHMASK & (1 << 1)) {
        pg8::Gemm g{HA, Wqkv_t, DM, DM, DM, 0, 0}; pg8::StaticOrder S; S.init(MREAL, NQKV, G, bx);
        EpiQKV E{Qb, Kb, Vb, RS0, 0.125f * LOG2E};
        pg8::gemm_phase(lds, g, S, E, wave);
        { const int t_ = fresh_tid(wave); meta_gemm<0>(HA + (size_t)MREAL * DM, DM, Wqkv_t, NQKV, DM, gw, NGW, t_ & 63, RS0, Qb, Kb, Vb, nullptr); }
    }
    xcd_barrier(xbar);
    if (PHMASK & 4) attn_phase(lds, Qb, Kb, Vb, P.sinks, vcu, G, wave);
    xcd_barrier(xbar);
    REP(3) if (PHMASK & (1 << 3)) {
        pg8::Gemm g{Qb, Wo_t, DM, DM, DM, 0, 0}; pg8::StaticOrder S; S.init(MREAL, DM, G, bx);
        EpiResid E{HA, HB, SS1};
        pg8::gemm_phase(lds, g, S, E, wave);
        { const int t_ = fresh_tid(wave); meta_gemm<1>(Qb + (size_t)MREAL * DM, DM, Wo_t, DM, DM, gw, NGW, t_ & 63, nullptr, HB, nullptr, nullptr, HA); }
    }
    xcd_barrier(xbar);
    REP(4) if (PHMASK & (1 << 4)) {
        pg8::Gemm g{HB, Wup0_t, DM, DM, DM, 0, 0}; pg8::StaticOrder S; S.init(MREAL, FF, G, bx);
        EpiUp<16> E{SS1, ACT};
        pg8::gemm_phase(lds, g, S, E, wave);
        { const int t_ = fresh_tid(wave); meta_gemm<2>(HB + (size_t)MREAL * DM, DM, Wup0_t, FF, DM, gw, NGW, t_ & 63, nullptr, ACT, nullptr, nullptr, nullptr); }
    }
    xcd_barrier(xbar);
    REP(5) if (PHMASK & (1 << 5)) {
        pg8::Gemm g{ACT, Wdn0_t, FF, FF, FF, 0, 0}; pg8::StaticOrder S; S.init(MREAL, DM, G, bx);
        EpiResid E{HB, HA, nullptr};
        pg8::gemm_phase(lds, g, S, E, wave);
        { const int t_ = fresh_tid(wave); meta_gemm<3>(ACT + (size_t)MREAL * FF, FF, Wdn0_t, DM, FF, gw, NGW, t_ & 63, nullptr, HA, nullptr, nullptr, HB); }
    }
    xcd_barrier(xbar);
    REP(6) if (PHMASK & (1 << 6)) {
        const int t_ = fresh_tid(wave); const int tid = t_, lane = tid & 63; (void)tid; (void)lane;
        f32x4 wv[4];
#pragma unroll
        for (int j = 0; j < 4; ++j) wv[j] = *(const f32x4*)(P.ssm_nw + lane * 16 + 4 * j);
        for (int ch = gw; ch < NCH + 1; ch += NGW) {
            const bool mt = ch == NCH;
            for (int ti = 0; ti < 16; ++ti) {
                const size_t row = mt ? (size_t)(MREAL + ti) : (size_t)ch * 16 + ti;
                const u32x4* hp = (const u32x4*)(HA + row * DM + lane * 16);
                f32x4 v[4]; unpack8(hp[0], v[0], v[1]); unpack8(hp[1], v[2], v[3]);
                float s = 0.f;
#pragma unroll
                for (int j = 0; j < 4; ++j) s += (v[j].x * v[j].x + v[j].y * v[j].y) + (v[j].z * v[j].z + v[j].w * v[j].w);
                s = wave_sum(s); const float rs = 1.0f / sqrtf(s * (1.0f / DM) + EPS);
#pragma unroll
                for (int j = 0; j < 4; ++j) v[j] = v[j] * rs * wv[j];
                bf16_t* dst = mt ? UM + lane * 256 + ti * 16 : UX + ((size_t)lane * NCH + ch) * UXLD + ti * 16;
                *(u32x4*)dst = pack8(v[0], v[1]); *(u32x4*)(dst + 8) = pack8(v[2], v[3]);
            }
        }
    }
    xcd_barrier(xbar);
    REP(7) if (PHMASK & (1 << 7)) {
        pg8::Gemm g{UX, BW1, 256, UXLD, 256, (size_t)NCH * UXLD, (size_t)256 * 256}; pg8::BatchOrder S{G, bx};
        EpiS E{Sst};
        pg8::gemm_phase(lds, g, S, E, wave);
    }
    xcd_barrier(xbar);
    REP(8) if (PHMASK & 256) {
        const int t_ = fresh_tid(wave); const int tid = t_, lane = tid & 63; (void)tid; (void)lane;
      if (tid < 256) {
        const int item = bx * 256 + tid;
        if (item < NB * 64 * 64) {
            const int p = item & 63, g = (item >> 6) & 63, b = item >> 12;
            const float ar = A16[2 * (g * 64 + p)], ai = A16[2 * (g * 64 + p) + 1];
            float xr = 0.f, xi = 0.f;
            { const bf16_t* um = UM + g * 256; const bf16_t* w0 = BW1 + ((size_t)g * 256 + 2 * p) * 256; const bf16_t* w1 = w0 + 256;
                for (int k = 0; k < 256; k += 8) { f32x4 u0, u1, a0, a1, b0, b1; unpack8(*(const u32x4*)(um + k), u0, u1); unpack8(*(const u32x4*)(w0 + k), a0, a1); unpack8(*(const u32x4*)(w1 + k), b0, b1);
#pragma unroll
                    for (int i = 0; i < 4; ++i) { xr += u0[i] * a0[i] + u1[i] * a1[i]; xi += u0[i] * b0[i] + u1[i] * b1[i]; } } }
            const float* sp = Sst + ((size_t)g * NCH + b * 256) * 128 + 2 * p;
            bf16_t* xp = UX + ((size_t)g * NCH + b * 256) * UXLD + 256 + 2 * p;
            for (int j0 = 0; j0 < 256; j0 += 16) {
                f32x2_t sv[16];
#pragma unroll
                for (int j = 0; j < 16; ++j) sv[j] = *(const f32x2_t*)(sp + (size_t)(j0 + j) * 128);
#pragma unroll
                for (int j = 0; j < 16; ++j) { *(unsigned*)(xp + (size_t)(j0 + j) * UXLD) = cvtpk(xr, xi);
                    const float nr = ar * xr - ai * xi + sv[j].x, ni = ar * xi + ai * xr + sv[j].y; xr = nr; xi = ni; }
            }
        }
      }
    }
    xcd_barrier(xbar);
    REP(9) if (PHMASK & (1 << 9)) {
        pg8::Gemm g{UX, BW2, UXLD, UXLD, UXLD, (size_t)NCH * UXLD, (size_t)256 * UXLD}; pg8::BatchOrder S{G, bx};
        EpiY E{UX, P.dsk, Yb};
        pg8::gemm_phase(lds, g, S, E, wave);
    }
    xcd_barrier(xbar);
    REP(10) if (PHMASK & (1 << 10)) {
        pg8::Gemm g{Yb, Wglu_t, DM, DM, DM, 0, 0}; pg8::StaticOrder S; S.init(MREAL, 2 * DM, G, bx);
        EpiGLU E{HA, HB, SS3};
        pg8::gemm_phase(lds, g, S, E, wave);
    }
    xcd_barrier(xbar);
    REP(11) if (PHMASK & (1 << 11)) {
        pg8::Gemm g{HB, Wup1_t, DM, DM, DM, 0, 0}; pg8::StaticOrder S; S.init(MREAL, FF, G, bx);
        EpiUp<32> E{SS3, ACT};
        pg8::gemm_phase(lds, g, S, E, wave);
    }
    xcd_barrier(xbar);
    REP(12) if (PHMASK & (1 << 12)) {
        pg8::Gemm g{ACT, Wdn1_t, FF, FF, FF, 0, 0}; pg8::StaticOrder S; S.init(MREAL, DM, G, bx);
        EpiResid E{HB, HA, SS4};
        pg8::gemm_phase(lds, g, S, E, wave);
    }
    xcd_barrier(xbar);
    for (int xs_ = 0; xs_ < XSYNC; ++xs_) xcd_barrier(xbar);
    REP(13) if (PHMASK & (1 << 13)) {
        const int t_ = fresh_tid(wave); const int tid = t_, lane = tid & 63; (void)tid; (void)lane;
      for (int m = gw; m < MREAL; m += NGW) {
        const float sl = (lane < 16) ? SS4[(size_t)m * 16 + lane] : 0.f;
        const float rs = 1.0f / sqrtf(wave_sum(sl) * (1.0f / DM) + EPS);
        const u32x4* hp = (const u32x4*)(HA + (size_t)m * DM);
        f32x4* op = (f32x4*)(P.out + (size_t)m * DM);
#pragma unroll
        for (int j = 0; j < 2; ++j) { f32x4 v0, v1; unpack8(hp[64 * j + lane], v0, v1);
            const f32x4 w0 = *(const f32x4*)(P.fnw + (64 * j + lane) * 8), w1 = *(const f32x4*)(P.fnw + (64 * j + lane) * 8 + 4);
            op[(64 * j + lane) * 2] = v0 * rs * w0; op[(64 * j + lane) * 2 + 1] = v1 * rs * w1; }
      }
    }
}

extern "C" void kernel_launch(void* const* d_in, const int* in_sizes, int n_in, void* d_out, int out_size, void* d_ws, size_t ws_size, hipStream_t stream) {
    static int grid = 0;
    if (grid == 0) {
        if (n_in != 20 || ws_size < WS_END) { fprintf(stderr, "kernel_launch: unexpected n_in %d or ws_size %zu (need %zu)\n", n_in, ws_size, (size_t)WS_END); grid = -1; return; }
        int dev = 0, cus = 0, per_cu = 0;
        hipGetDevice(&dev); hipDeviceGetAttribute(&cus, hipDeviceAttributeMultiprocessorCount, dev);
        hipFuncSetAttribute((const void*)fwd_kernel, hipFuncAttributeMaxDynamicSharedMemorySize, LDS_BYTES);
        hipOccupancyMaxActiveBlocksPerMultiprocessor(&per_cu, (const void*)fwd_kernel, 512, LDS_BYTES);
        if (per_cu < 1) { fprintf(stderr, "kernel_launch: occupancy query says %d blocks/CU\n", per_cu); per_cu = 1; }
        (void)hipGetLastError();
        grid = cus;
    }
    if (grid < 0) return;
    Params p{};
    p.x = (const float*)d_in[0]; p.meta = (const float*)d_in[1]; p.attn_nw = (const float*)d_in[2]; p.wqkv = (const float*)d_in[3]; p.sinks = (const float*)d_in[4]; p.wo = (const float*)d_in[5];
    p.ssm_nw = (const float*)d_in[6]; p.lre = (const float*)d_in[7]; p.lim = (const float*)d_in[8]; p.logdt = (const float*)d_in[9]; p.bre = (const float*)d_in[10]; p.bim = (const float*)d_in[11];
    p.cre = (const float*)d_in[12]; p.cim = (const float*)d_in[13]; p.dsk = (const float*)d_in[14]; p.wglu = (const float*)d_in[15]; p.mlp_nw = (const float*)d_in[16]; p.wup = (const float*)d_in[17];
    p.wdn = (const float*)d_in[18]; p.fnw = (const float*)d_in[19]; p.out = (float*)d_out; p.ws = (unsigned char*)d_ws;
    if (hipMemsetAsync((char*)d_ws + WS_CTL, 0, XCD_BAR_WORDS * 4, stream) != hipSuccess) { fprintf(stderr, "kernel_launch: memset failed\n"); return; }
    void* args[] = {&p};
    hipError_t e = hipLaunchCooperativeKernel((const void*)fwd_kernel, dim3(grid), dim3(512), args, LDS_BYTES, stream);
    if (e != hipSuccess) fprintf(stderr, "cooperative launch failed: %s (grid %d)\n", hipGetErrorString(e), grid);
}
```

```cpp
#include <hip/hip_runtime.h>
#include <hip/hip_cooperative_groups.h>
#include <cstdio>
#include <cstdint>
namespace cg = cooperative_groups;
#ifndef EPI2
#define EPI2 0
#endif
#ifndef DUPMASK
#define DUPMASK 0
#endif
#ifndef XSYNC
#define XSYNC 0
#endif

#define LAS __attribute__((address_space(3)))
typedef unsigned short bf16_t;
typedef short bf16x8 __attribute__((ext_vector_type(8)));
typedef float f32x4 __attribute__((ext_vector_type(4)));
typedef float f32x16 __attribute__((ext_vector_type(16)));
typedef unsigned u32x4 __attribute__((ext_vector_type(4)));
typedef unsigned u32x2 __attribute__((ext_vector_type(2)));
typedef float f32x2_t __attribute__((ext_vector_type(2)));
typedef __bf16 bf16x2_t __attribute__((ext_vector_type(2)));

__device__ __forceinline__ unsigned cvtpk(float lo, float hi) { f32x2_t v = {lo, hi}; bf16x2_t b = __builtin_convertvector(v, bf16x2_t); return __builtin_bit_cast(unsigned, b); }
__device__ __forceinline__ float bflo(unsigned w) { return __uint_as_float(w << 16); }
__device__ __forceinline__ float bfhi(unsigned w) { return __uint_as_float(w & 0xffff0000u); }

__device__ __forceinline__ int fresh_tid(int wave) { int l; asm volatile("v_mbcnt_lo_u32_b32 %0, -1, 0\n\tv_mbcnt_hi_u32_b32 %0, -1, %0" : "=v"(l)); return wave * 64 + l; }
template <int X> __device__ __forceinline__ float xshfl(float v) {
    if (X == 32) { auto rr = __builtin_amdgcn_permlane32_swap(__float_as_uint(v), __float_as_uint(v), false, false);
        const int l = __builtin_amdgcn_mbcnt_lo(~0u, 0u); (void)l; return 0.f; }
    return __uint_as_float((unsigned)__builtin_amdgcn_ds_swizzle((int)__float_as_uint(v), (X << 10) | 0x1f));
}
__device__ __forceinline__ float sum32(float v) { auto rr = __builtin_amdgcn_permlane32_swap(__float_as_uint(v), __float_as_uint(v), false, false); return __uint_as_float(rr[0]) + __uint_as_float(rr[1]); }
__device__ __forceinline__ float max32(float v) { auto rr = __builtin_amdgcn_permlane32_swap(__float_as_uint(v), __float_as_uint(v), false, false); return fmaxf(__uint_as_float(rr[0]), __uint_as_float(rr[1])); }

constexpr int DM = 1024, NB = 16, SEQ = 4096, NMETA = 16, FF = 4096;
constexpr int MREAL = NB * SEQ;
constexpr int MALL = MREAL + 256;
constexpr int NQKV = 1536;
constexpr float EPS = 1e-6f;
constexpr float LOG2E = 1.4426950408889634f;
constexpr int NCH = MREAL / 16;
constexpr int UXLD = 384;

constexpr size_t MiB = 1u << 20;
constexpr size_t WS_WQKV = 0, WS_WO = 3 * MiB, WS_WUP0 = 5 * MiB, WS_WDN0 = 13 * MiB, WS_WGLU = 21 * MiB, WS_WUP1 = 25 * MiB, WS_WDN1 = 33 * MiB;
constexpr size_t WS_BW1 = 41 * MiB, WS_BW2 = 49 * MiB, WS_A16 = 61 * MiB, WS_UM = 61 * MiB + 65536, WS_RS0 = 62 * MiB;
constexpr size_t WS_SS1 = 63 * MiB, WS_SS3 = 68 * MiB, WS_SS4 = 76 * MiB;
constexpr size_t WS_CTL = 81 * MiB;
constexpr size_t WS_RA = 82 * MiB, WS_RB = 211 * MiB, WS_RC = 340 * MiB;
constexpr size_t WS_Q = WS_RC, WS_K = WS_RC + 129 * MiB, WS_V = WS_RC + 162 * MiB;
constexpr size_t WS_ACT = WS_RC;
constexpr size_t WS_UX = WS_RC, WS_S = WS_RC + 192 * MiB, WS_Y = WS_RC + 320 * MiB;
constexpr size_t WS_END = WS_RC + 514 * MiB;

namespace pg8 {
constexpr int BM = 256, BK = 64, HALF = 128, HTB = HALF * BK * 2, STAGE_BYTES = 8 * HTB, NXCD = 8, WGM = 8;
__host__ __device__ __forceinline__ int lds_byte(int r, int c) { const int st = (r >> 4) * 2 + (c >> 5), rr = r & 15, cc = c & 31, ob = rr * 64 + cc * 2; return st * 1024 + (ob ^ (((ob >> 9) & 1) << 5)); }
__host__ __device__ __forceinline__ void stage_rc(int b, int& R, int& C) { const int st = b / 1024, sb = b % 1024, swz = sb ^ (((sb >> 9) & 1) << 5); R = (st >> 1) * 16 + swz / 64; C = (st & 1) * 32 + (swz % 64) / 2; }
__host__ __device__ __forceinline__ int perm32(int rho) { const int n = rho >> 4, i = rho & 15; return 8 * (i >> 2) + 4 * n + (i & 3); }

struct Unit { int pm, pn, pb; };
struct Gemm { const bf16_t* A; const bf16_t* Bt; int K, lda, ldb; size_t bsA, bsB; };

struct StaticOrder {
    int nM, nN, nwg, G, c;
    __device__ void init(int M, int N, int G_, int c_) { nM = M / BM; nN = N / BM; nwg = nM * nN; G = G_; c = c_; }
    __device__ bool next(int i, Unit& u) const {
        const long L = (long)i * G + c; if (L >= nwg) return false;
        int wgid = (int)L; { const int q = nwg / NXCD, r = nwg % NXCD, xcd = wgid % NXCD, off = wgid / NXCD; wgid = (xcd < r ? xcd * (q + 1) : r * (q + 1) + (xcd - r) * q) + off; }
        const int nig = WGM * nN, gid = wgid / nig, fm = gid * WGM, gsz = (nM - fm) < WGM ? (nM - fm) : WGM;
        u.pm = fm + ((wgid % nig) % gsz); u.pn = (wgid % nig) / gsz; u.pb = 0; return true;
    }
};
struct BatchOrder {
    int G, c;
    __device__ bool next(int i, Unit& u) const { const int L = i * G + c; if (L >= 64 * 16) return false; u.pb = L >> 4; u.pm = L & 15; u.pn = 0; return true; }
};

template <class Epi, class Sched>
__device__ __forceinline__ void gemm_phase(LAS unsigned char* lds, const Gemm g, const Sched& S, const Epi& E, int wave_, unsigned stag = 0) {
    if (stag > 7u) { const unsigned long long t0_ = __builtin_amdgcn_s_memrealtime(); const unsigned long long w_ = (unsigned long long)(blockIdx.x >> 3) * stag / 32;
        while (__builtin_amdgcn_s_memrealtime() - t0_ < w_) __builtin_amdgcn_s_sleep(8); }
    const int tid_ = fresh_tid(wave_);
    const int tid = tid_, wid = wave_, lane = tid & 63, wr = wid >> 2, wc = wid & 3, fr = lane & 15, fq = lane >> 4;
    const int K = g.K, nt = K / BK;
    unsigned voffA[2], voffB[2];
#pragma unroll
    for (int i = 0; i < 2; ++i) { int R, C; stage_rc(tid * 16 + i * 8192, R, C); const int Rb = (R & ~31) + perm32(R & 31);
        voffA[i] = (unsigned)(R * g.lda + C) * 2u; voffB[i] = (unsigned)(Rb * g.ldb + C) * 2u; }
    const size_t kstep = (size_t)(BK * 2);
    const size_t hA = (size_t)HALF * g.lda * 2, hB = (size_t)HALF * g.ldb * 2;
    const size_t tA = 2 * hA, tB = 2 * hB;
    const unsigned ldsw = (unsigned)wid * 1024u;
    const int aoff = lds_byte(wr * 64 + fr, fq * 8), boff = lds_byte(wc * 32 + fr, fq * 8);
#define PG8_SA(b, h) (((b) * 2 + (h)) * HTB)
#define PG8_SB(b, h) ((4 + (b) * 2 + (h)) * HTB)
#define PG8_STAGE(bufoff, gbase, voff) do { _Pragma("unroll") for (int _i = 0; _i < 2; ++_i) \
        __builtin_amdgcn_global_load_lds((const unsigned*)((const char*)(gbase) + (voff)[_i]), (LAS unsigned*)(lds + (bufoff) + ldsw + _i * 8192), 16, 0, 0); } while (0)
#define PG8_LDA(dst, b, h) do { _Pragma("unroll") for (int m = 0; m < 4; ++m) _Pragma("unroll") for (int k = 0; k < 2; ++k) dst[m][k] = *(const LAS bf16x8*)(lds + PG8_SA(b, h) + aoff + m * 2048 + k * 1024); } while (0)
#define PG8_LDB(dst, b, h) do { _Pragma("unroll") for (int n = 0; n < 2; ++n) _Pragma("unroll") for (int k = 0; k < 2; ++k) dst[n][k] = *(const LAS bf16x8*)(lds + PG8_SB(b, h) + boff + n * 2048 + k * 1024); } while (0)
#define PG8_MMA(ai, bj, At, Bt) do { __builtin_amdgcn_s_setprio(1); _Pragma("unroll") for (int m = 0; m < 4; ++m) _Pragma("unroll") for (int n = 0; n < 2; ++n) _Pragma("unroll") for (int k = 0; k < 2; ++k) \
        acc[ai][bj][m][n] = __builtin_amdgcn_mfma_f32_16x16x32_bf16(Bt[n][k], At[m][k], acc[ai][bj][m][n], 0, 0, 0); __builtin_amdgcn_s_setprio(0); } while (0)
#define PG8_WAIT_V(n) asm volatile("s_waitcnt vmcnt(" #n ")" ::: "memory")
#define PG8_WAIT_L(n) asm volatile("s_waitcnt lgkmcnt(" #n ")" ::: "memory")
#define PG8_BAR __builtin_amdgcn_s_barrier()
#define PG8_SCHED __builtin_amdgcn_sched_barrier(0)
    Unit cur, nxt; int ui = 0;
    if (!S.next(0, cur)) return;
    f32x4 acc[2][2][4][2];
#pragma unroll
    for (int a = 0; a < 2; ++a)
#pragma unroll
        for (int b = 0; b < 2; ++b)
#pragma unroll
            for (int m = 0; m < 4; ++m)
#pragma unroll
                for (int n = 0; n < 2; ++n) acc[a][b][m][n] = (f32x4){0.f, 0.f, 0.f, 0.f};
    bf16x8 At[4][2], B0[2][2], B1[2][2];
    const char* cA = (const char*)g.A + (size_t)cur.pb * g.bsA * 2 + (size_t)cur.pm * tA;
    const char* cB = (const char*)g.Bt + (size_t)cur.pb * g.bsB * 2 + (size_t)cur.pn * tB;
    PG8_STAGE(PG8_SB(0, 0), cB, voffB); PG8_STAGE(PG8_SB(0, 1), cB + hB, voffB); PG8_STAGE(PG8_SA(0, 0), cA, voffA); PG8_STAGE(PG8_SA(0, 1), cA + hA, voffA);
    if (wr == 1) PG8_BAR;
    PG8_WAIT_V(2); PG8_BAR;
    PG8_STAGE(PG8_SB(1, 0), cB + kstep, voffB); PG8_STAGE(PG8_SA(1, 0), cA + kstep, voffA); PG8_STAGE(PG8_SB(1, 1), cB + hB + kstep, voffB);
    PG8_WAIT_V(6); PG8_BAR;
    for (;;) {
        const bool has_next = S.next(ui + 1, nxt);
        const char* nA = has_next ? (const char*)g.A + (size_t)nxt.pb * g.bsA * 2 + (size_t)nxt.pm * tA : cA;
        const char* nB = has_next ? (const char*)g.Bt + (size_t)nxt.pb * g.bsB * 2 + (size_t)nxt.pn * tB : cB;
#pragma unroll 1
        for (int t = 0; t < nt; t += 2) {
            const bool last = (t == nt - 2);
            const char* a1 = cA + (size_t)(t + 1) * kstep;
            const char* a2 = last ? nA : cA + (size_t)(t + 2) * kstep; const char* b2 = last ? nB : cB + (size_t)(t + 2) * kstep;
            const char* a3 = a2 + kstep; const char* b3 = b2 + kstep;
            PG8_LDB(B0, 0, 0); PG8_LDB(B1, 0, 1); PG8_SCHED; PG8_LDA(At, 0, 0); PG8_STAGE(PG8_SA(1, 1), a1 + hA, voffA);
            PG8_WAIT_V(8); PG8_WAIT_L(0); PG8_BAR; PG8_MMA(0, 0, At, B0); PG8_MMA(0, 1, At, B1); PG8_BAR; PG8_SCHED;
            PG8_LDA(At, 0, 1); PG8_STAGE(PG8_SB(0, 0), b2, voffB); PG8_STAGE(PG8_SB(0, 1), b2 + hB, voffB); PG8_STAGE(PG8_SA(0, 0), a2, voffA);
            PG8_WAIT_V(8); PG8_WAIT_L(0); PG8_BAR; PG8_MMA(1, 0, At, B0); PG8_MMA(1, 1, At, B1); PG8_BAR; PG8_SCHED;
            PG8_LDB(B0, 1, 0); PG8_LDB(B1, 1, 1); PG8_SCHED; PG8_LDA(At, 1, 0); PG8_STAGE(PG8_SA(0, 1), a2 + hA, voffA);
            PG8_WAIT_V(8); PG8_WAIT_L(0); PG8_BAR; PG8_MMA(0, 0, At, B0); PG8_MMA(0, 1, At, B1); PG8_BAR; PG8_SCHED;
            PG8_LDA(At, 1, 1); PG8_STAGE(PG8_SB(1, 0), b3, voffB); PG8_STAGE(PG8_SB(1, 1), b3 + hB, voffB); PG8_STAGE(PG8_SA(1, 0), a3, voffA);
            PG8_WAIT_V(8); PG8_WAIT_L(0); PG8_BAR; PG8_MMA(1, 0, At, B0); PG8_MMA(1, 1, At, B1); PG8_BAR; PG8_SCHED;
        }
        if (wr == 0) PG8_BAR;
        E(acc, cur, wr, wc, fr, fq);
        if (EPI2 && stag == 7u) { asm volatile("" ::: "memory"); E(acc, cur, wr, wc, fr, fq); }
        if (!has_next) break;
#pragma unroll
        for (int a = 0; a < 2; ++a)
#pragma unroll
            for (int b = 0; b < 2; ++b)
#pragma unroll
                for (int m = 0; m < 4; ++m)
#pragma unroll
                    for (int n = 0; n < 2; ++n) acc[a][b][m][n] = (f32x4){0.f, 0.f, 0.f, 0.f};
        cur = nxt; cA = nA; cB = nB; ++ui;
        if (wr == 1) PG8_BAR;
    }
    PG8_WAIT_V(0);
    PG8_BAR;
#undef PG8_SA
#undef PG8_SB
#undef PG8_STAGE
#undef PG8_LDA
#undef PG8_LDB
#undef PG8_MMA
#undef PG8_WAIT_V
#undef PG8_WAIT_L
#undef PG8_BAR
#undef PG8_SCHED
}
}
using pg8::Unit;
typedef f32x4 AccT[2][2][4][2];
__device__ __forceinline__ float wave_sum(float v) {
    v += xshfl<1>(v); v += xshfl<2>(v); v += xshfl<4>(v); v += xshfl<8>(v); v += xshfl<16>(v); return sum32(v);
}


__device__ __forceinline__ u32x4 pack8(f32x4 v0, f32x4 v1) { u32x4 w; w.x = cvtpk(v0[0], v0[1]); w.y = cvtpk(v0[2], v0[3]); w.z = cvtpk(v1[0], v1[1]); w.w = cvtpk(v1[2], v1[3]); return w; }
__device__ __forceinline__ void unpack8(u32x4 w, f32x4& v0, f32x4& v1) { v0 = (f32x4){bflo(w.x), bfhi(w.x), bflo(w.y), bfhi(w.y)}; v1 = (f32x4){bflo(w.z), bfhi(w.z), bflo(w.w), bfhi(w.w)}; }

template <int NS> __device__ __forceinline__ float row_rs(const float* SS, int r, int fq) {
    float s;
    if (NS == 16) { const f32x4 a = *(const f32x4*)(SS + (size_t)r * 16 + fq * 4); s = (a[0] + a[1]) + (a[2] + a[3]); }
    else { const f32x4 a = *(const f32x4*)(SS + (size_t)r * 32 + fq * 8), b = *(const f32x4*)(SS + (size_t)r * 32 + fq * 8 + 4); s = ((a[0] + a[1]) + (a[2] + a[3])) + ((b[0] + b[1]) + (b[2] + b[3])); }
    s += xshfl<16>(s); s = sum32(s);
    return __builtin_amdgcn_rsqf(s * (1.0f / DM) + EPS);
}

struct XS { LAS u32x4* p; int lane; };
__device__ __forceinline__ void lane_tr2(const XS& x, int fr, int fq, u32x4& w0, u32x4& w1) {
    x.p[fr * 4 + fq] = w0; x.p[64 + fr * 4 + fq] = w1;
    w0 = x.p[x.lane]; w1 = x.p[64 + x.lane];
}
__device__ __forceinline__ void lane_tr1(const XS& x, int fr, int fq, u32x4& w0) { x.p[fr * 4 + fq] = w0; w0 = x.p[x.lane]; }
struct EpiQKV {
    bf16_t* Q; bf16_t* Kb; bf16_t* Vb; const float* rs; float qscale; XS xs;
    __device__ __forceinline__ void operator()(const AccT& acc, const Unit& u, int wr, int wc, int fr, int fq) const {
        const int row0 = u.pm * 256 + wr * 64 + fr;
        bf16_t* base; int ld, cb; float sc;
        if (u.pn < 4) { base = Q; ld = DM; cb = u.pn * 256; sc = qscale; } else if (u.pn == 4) { base = Kb; ld = 256; cb = 0; sc = 1.f; } else { base = Vb; ld = 256; cb = 0; sc = 1.f; }
        const int col0 = cb + wc * 32 + 8 * fq;
        float s[2][4];
#pragma unroll
        for (int ai = 0; ai < 2; ++ai)
#pragma unroll
            for (int m = 0; m < 4; ++m) s[ai][m] = rs[row0 + ai * 128 + m * 16] * sc;
        asm volatile("" ::: "memory");
#pragma unroll
        for (int ai = 0; ai < 2; ++ai)
#pragma unroll
            for (int m = 0; m < 4; ++m) { const int r = row0 - fr + (xs.lane >> 2) + ai * 128 + m * 16; bf16_t* rowp = base + (size_t)r * ld + cb + wc * 32 + 8 * (xs.lane & 3);
                u32x4 w0 = pack8(acc[ai][0][m][0] * s[ai][m], acc[ai][0][m][1] * s[ai][m]), w1 = pack8(acc[ai][1][m][0] * s[ai][m], acc[ai][1][m][1] * s[ai][m]);
                lane_tr2(xs, fr, fq, w0, w1); *(u32x4*)rowp = w0; *(u32x4*)(rowp + 128) = w1; }
    }
};
struct EpiResid {
    const bf16_t* Hin; bf16_t* Hout; float* SS; XS xs;
    __device__ __forceinline__ void operator()(const AccT& acc, const Unit& u, int wr, int wc, int fr, int fq) const {
        const int row0 = u.pm * 256 + wr * 64 + fr, col0 = u.pn * 256 + wc * 32 + 8 * fq;
        u32x4 hr[2][4][2];
#pragma unroll
        for (int ai = 0; ai < 2; ++ai)
#pragma unroll
            for (int m = 0; m < 4; ++m)
#pragma unroll
                for (int bj = 0; bj < 2; ++bj) hr[ai][m][bj] = *(const u32x4*)(Hin + (size_t)(row0 + ai * 128 + m * 16) * DM + col0 + bj * 128);
        asm volatile("" ::: "memory");
#pragma unroll
        for (int ai = 0; ai < 2; ++ai)
#pragma unroll
            for (int m = 0; m < 4; ++m) { const int r = row0 + ai * 128 + m * 16; float q = 0.f; u32x4 wv[2];
#pragma unroll
                for (int bj = 0; bj < 2; ++bj) { f32x4 h0, h1; unpack8(hr[ai][m][bj], h0, h1);
                    const f32x4 v0 = acc[ai][bj][m][0] + h0, v1 = acc[ai][bj][m][1] + h1;
                    q += (v0[0] * v0[0] + v0[1] * v0[1]) + (v0[2] * v0[2] + v0[3] * v0[3]) + (v1[0] * v1[0] + v1[1] * v1[1]) + (v1[2] * v1[2] + v1[3] * v1[3]);
                    wv[bj] = pack8(v0, v1); }
                lane_tr2(xs, fr, fq, wv[0], wv[1]);
                { bf16_t* op = Hout + (size_t)(r - fr + (xs.lane >> 2)) * DM + u.pn * 256 + wc * 32 + 8 * (xs.lane & 3); *(u32x4*)op = wv[0]; *(u32x4*)(op + 128) = wv[1]; }
                if (SS) { q += xshfl<16>(q); q = sum32(q); if (fq == 0) SS[(size_t)r * 16 + u.pn * 4 + wc] = q; } }
    }
};
template <int NS> struct EpiUp {
    const float* SS; bf16_t* ACT; XS xs;
    __device__ __forceinline__ void operator()(const AccT& acc, const Unit& u, int wr, int wc, int fr, int fq) const {
        const int row0 = u.pm * 256 + wr * 64 + fr, col0 = u.pn * 256 + wc * 32 + 8 * fq;
        float s[2][4];
#pragma unroll
        for (int ai = 0; ai < 2; ++ai)
#pragma unroll
            for (int m = 0; m < 4; ++m) { const int r = row0 + ai * 128 + m * 16;
                if (NS == 16) { const f32x4 a = *(const f32x4*)(SS + (size_t)r * 16 + fq * 4); s[ai][m] = (a[0] + a[1]) + (a[2] + a[3]); }
                else { const f32x4 a = *(const f32x4*)(SS + (size_t)r * 32 + fq * 8), b = *(const f32x4*)(SS + (size_t)r * 32 + fq * 8 + 4); s[ai][m] = ((a[0] + a[1]) + (a[2] + a[3])) + ((b[0] + b[1]) + (b[2] + b[3])); } }
        asm volatile("" ::: "memory");
#pragma unroll
        for (int ai = 0; ai < 2; ++ai)
#pragma unroll
            for (int m = 0; m < 4; ++m) { float t = s[ai][m]; t += xshfl<16>(t); t = sum32(t); s[ai][m] = __builtin_amdgcn_rsqf(t * (1.0f / DM) + EPS); }
#pragma unroll
        for (int ai = 0; ai < 2; ++ai)
#pragma unroll
            for (int m = 0; m < 4; ++m) { const int r = row0 - fr + (xs.lane >> 2) + ai * 128 + m * 16; const float sc = s[ai][m]; bf16_t* rowp = ACT + (size_t)r * FF + u.pn * 256 + wc * 32 + 8 * (xs.lane & 3); u32x4 wv[2];
#pragma unroll
                for (int bj = 0; bj < 2; ++bj) { f32x4 v0 = acc[ai][bj][m][0] * sc, v1 = acc[ai][bj][m][1] * sc;
#pragma unroll
                    for (int i = 0; i < 4; ++i) { const float a = fmaxf(v0[i], 0.f), b = fmaxf(v1[i], 0.f); v0[i] = a * a; v1[i] = b * b; }
                    wv[bj] = pack8(v0, v1); }
                lane_tr2(xs, fr, fq, wv[0], wv[1]); *(u32x4*)rowp = wv[0]; *(u32x4*)(rowp + 128) = wv[1]; }
    }
};
struct EpiS {
    float* S;
    __device__ __forceinline__ void operator()(const AccT& acc, const Unit& u, int wr, int wc, int fr, int fq) const {
        const int row0 = u.pm * 256 + wr * 64 + fr, col0 = wc * 32 + 8 * fq;
#pragma unroll
        for (int ai = 0; ai < 2; ++ai)
#pragma unroll
            for (int m = 0; m < 4; ++m) { const int r = row0 + ai * 128 + m * 16; float* p = S + ((size_t)u.pb * NCH + r) * 128 + col0;
                *(f32x4*)p = acc[ai][0][m][0]; *(f32x4*)(p + 4) = acc[ai][0][m][1]; }
    }
};
__device__ __forceinline__ float gelu_tanh(float x) { const float z = 0.7978845608028654f * (x + 0.044715f * x * x * x); return x * __builtin_amdgcn_rcpf(1.0f + __builtin_amdgcn_exp2f(-2.0f * LOG2E * z)); }
struct EpiY {
    const bf16_t* UX; const float* Dsk; bf16_t* Y; XS xs;
    __device__ __forceinline__ void operator()(const AccT& acc, const Unit& u, int wr, int wc, int fr, int fq) const {
        const int g = u.pb; const int r0 = u.pm * 256 + wr * 64 + fr; const int colb = wc * 32 + 8 * fq, c0 = colb & 15;
        const f32x4 d0 = *(const f32x4*)(Dsk + g * 16 + c0), d1 = *(const f32x4*)(Dsk + g * 16 + c0 + 4);
        const unsigned offU0 = (unsigned)(((size_t)g * NCH + r0) * UXLD + colb) * 2u;
        const int colb2 = wc * 32 + 8 * (xs.lane & 3);
        unsigned offY = (unsigned)(((size_t)(r0 - fr + (xs.lane >> 2)) * 16 + (colb2 >> 4)) * DM + g * 16 + (colb2 & 15)) * 2u;
        u32x4 ur[2][4][2];
#pragma unroll
        for (int ai = 0; ai < 2; ++ai)
#pragma unroll
            for (int m = 0; m < 4; ++m)
#pragma unroll
                for (int bj = 0; bj < 2; ++bj) ur[ai][m][bj] = *(const u32x4*)((const char*)UX + offU0 + (unsigned)((ai * 128 + m * 16) * UXLD * 2 + bj * 256));
        asm volatile("" ::: "memory");
#pragma unroll
        for (int ai = 0; ai < 2; ++ai)
#pragma unroll
            for (int m = 0; m < 4; ++m) {
                asm volatile("" : "+v"(offY)); u32x4 wv[2];
#pragma unroll
                for (int bj = 0; bj < 2; ++bj) {
                    const u32x4 uw = ur[ai][m][bj]; u32x4 ow;
                    { f32x4 v = acc[ai][bj][m][0] + d0 * (f32x4){bflo(uw.x), bfhi(uw.x), bflo(uw.y), bfhi(uw.y)};
#pragma unroll
                      for (int i = 0; i < 4; ++i) v[i] = gelu_tanh(v[i]);
                      ow.x = cvtpk(v[0], v[1]); ow.y = cvtpk(v[2], v[3]); }
                    { f32x4 v = acc[ai][bj][m][1] + d1 * (f32x4){bflo(uw.z), bfhi(uw.z), bflo(uw.w), bfhi(uw.w)};
#pragma unroll
                      for (int i = 0; i < 4; ++i) v[i] = gelu_tanh(v[i]);
                      ow.z = cvtpk(v[0], v[1]); ow.w = cvtpk(v[2], v[3]); }
                    wv[bj] = ow; }
                lane_tr2(xs, fr, fq, wv[0], wv[1]);
                *(u32x4*)((char*)Y + offY) = wv[0]; *(u32x4*)((char*)Y + offY + 8 * DM * 2) = wv[1];
                offY += (m == 3 ? 80 : 16) * 16 * DM * 2;
            }
    }
};
struct EpiGLU {
    const bf16_t* Hin; bf16_t* Hout; float* SS; XS xs;
    __device__ __forceinline__ void operator()(const AccT& acc, const Unit& u, int wr, int wc, int fr, int fq) const {
        const int row0 = u.pm * 256 + wr * 64 + fr, col0 = u.pn * 128 + wc * 32 + 8 * fq;
        u32x4 hr[2][4];
#pragma unroll
        for (int ai = 0; ai < 2; ++ai)
#pragma unroll
            for (int m = 0; m < 4; ++m) hr[ai][m] = *(const u32x4*)(Hin + (size_t)(row0 + ai * 128 + m * 16) * DM + col0);
        asm volatile("" ::: "memory");
#pragma unroll
        for (int ai = 0; ai < 2; ++ai)
#pragma unroll
            for (int m = 0; m < 4; ++m) { const int r = row0 + ai * 128 + m * 16; const size_t off = (size_t)r * DM + col0;
                f32x4 h0, h1; unpack8(hr[ai][m], h0, h1);
                f32x4 v0, v1;
#pragma unroll
                for (int i = 0; i < 4; ++i) {
                    v0[i] = h0[i] + acc[ai][0][m][0][i] * __builtin_amdgcn_rcpf(1.0f + __builtin_amdgcn_exp2f(-LOG2E * acc[ai][1][m][0][i]));
                    v1[i] = h1[i] + acc[ai][0][m][1][i] * __builtin_amdgcn_rcpf(1.0f + __builtin_amdgcn_exp2f(-LOG2E * acc[ai][1][m][1][i])); }
                float q = (v0[0] * v0[0] + v0[1] * v0[1]) + (v0[2] * v0[2] + v0[3] * v0[3]) + (v1[0] * v1[0] + v1[1] * v1[1]) + (v1[2] * v1[2] + v1[3] * v1[3]);
                { u32x4 w = pack8(v0, v1); lane_tr1(xs, fr, fq, w); *(u32x4*)(Hout + (size_t)(r - fr + (xs.lane >> 2)) * DM + u.pn * 128 + wc * 32 + 8 * (xs.lane & 3)) = w; }
                q += xshfl<16>(q); q = sum32(q); if (fq == 0) SS[(size_t)r * 32 + u.pn * 4 + wc] = q; (void)off; }
    }
};

struct Params {
    const float* x; const float* meta; const float* attn_nw; const float* wqkv; const float* sinks; const float* wo;
    const float* ssm_nw; const float* lre; const float* lim; const float* logdt; const float* bre; const float* bim; const float* cre; const float* cim; const float* dsk; const float* wglu;
    const float* mlp_nw; const float* wup; const float* wdn; const float* fnw;
    float* out; unsigned char* ws;
};


__device__ __forceinline__ void transpose_item(const float* W, int K, int N, bf16_t* WT, const float* kscale, bool glu, LAS float* scr, int item, int lane) {
    const int nblk = N / 32, kb = item / nblk, nb = item % nblk, k0 = 64 * kb, n0 = 32 * nb;
#pragma unroll 8
    for (int i = 0; i < 32; ++i) { const int kk = 2 * i + (lane >> 5); float v = W[(size_t)(k0 + kk) * N + n0 + (lane & 31)]; if (kscale) v *= kscale[k0 + kk]; scr[kk * 33 + (lane & 31)] = v; }
    asm volatile("s_waitcnt lgkmcnt(0)" ::: "memory");
    const int c = lane & 7;
#pragma unroll
    for (int j = 0; j < 4; ++j) { const int n = (lane >> 3) + 8 * j; const LAS float* s = scr + (8 * c) * 33 + n;
        u32x4 o; o.x = cvtpk(s[0 * 33], s[1 * 33]); o.y = cvtpk(s[2 * 33], s[3 * 33]); o.z = cvtpk(s[4 * 33], s[5 * 33]); o.w = cvtpk(s[6 * 33], s[7 * 33]);
        int nd = n0 + n; if (glu) { const int bj = nd >> 10, rem = nd & 1023; nd = (rem >> 7) * 256 + bj * 128 + (rem & 127); }
        *(u32x4*)(WT + (size_t)nd * K + k0 + 8 * c) = o; }
    asm volatile("s_waitcnt lgkmcnt(0)" ::: "memory");
}

struct SsmP { float lr, li, dt; };
__device__ __forceinline__ void cpow(const SsmP& s, float tau, float& re, float& im) { const float mag = expf(s.lr * s.dt * tau); float sn, cs; sincosf(s.li * s.dt * tau, &sn, &cs); re = mag * cs; im = mag * sn; }
__device__ __forceinline__ void ccoef(const SsmP& s, float& re, float& im) {
    float ar, ai; cpow(s, 1.0f, ar, ai); ar -= 1.0f; const float den = 1.0f / (s.lr * s.lr + s.li * s.li);
    re = (ar * s.lr + ai * s.li) * den; im = (ai * s.lr - ar * s.li) * den;
}

template <int MODE> __device__ __forceinline__ void meta_gemm(const bf16_t* A, int lda, const bf16_t* Wt, int N, int K, int gw, int NGW, int lane,
                                                              const float* rs0, bf16_t* o0, bf16_t* o1, bf16_t* o2, const bf16_t* hin) {
    float rsv = 1.0f;
    if (MODE == 2) {
        for (int r = 0; r < 16; ++r) { f32x4 v0, v1, v2, v3; const u32x4* hp = (const u32x4*)(A + (size_t)r * lda + lane * 16); unpack8(hp[0], v0, v1); unpack8(hp[1], v2, v3);
            float s = (v0[0] * v0[0] + v0[1] * v0[1]) + (v0[2] * v0[2] + v0[3] * v0[3]) + (v1[0] * v1[0] + v1[1] * v1[1]) + (v1[2] * v1[2] + v1[3] * v1[3])
                    + (v2[0] * v2[0] + v2[1] * v2[1]) + (v2[2] * v2[2] + v2[3] * v2[3]) + (v3[0] * v3[0] + v3[1] * v3[1]) + (v3[2] * v3[2] + v3[3] * v3[3]);
            s = wave_sum(s); if (lane == r) rsv = 1.0f / sqrtf(s * (1.0f / DM) + EPS); }
    }
    for (int n = gw; n < N; n += NGW) {
        float acc[16];
#pragma unroll
        for (int r = 0; r < 16; ++r) acc[r] = 0.f;
        for (int k0 = lane * 8; k0 < K; k0 += 512) {
            f32x4 w0, w1; unpack8(*(const u32x4*)(Wt + (size_t)n * K + k0), w0, w1);
#pragma unroll
            for (int r = 0; r < 16; ++r) { f32x4 a0, a1; unpack8(*(const u32x4*)(A + (size_t)r * lda + k0), a0, a1);
                acc[r] += (a0[0] * w0[0] + a0[1] * w0[1]) + (a0[2] * w0[2] + a0[3] * w0[3]) + (a1[0] * w1[0] + a1[1] * w1[1]) + (a1[2] * w1[2] + a1[3] * w1[3]); }
        }
        float v = 0.f;
#pragma unroll
        for (int r = 0; r < 16; ++r) { const float s = wave_sum(acc[r]); v = (lane == r) ? s : v; }
        if (lane < 16) { const size_t row = MREAL + lane;
            if (MODE == 0) { v *= rs0[row]; bf16_t* dst; if (n < 1024) { v *= 0.125f * LOG2E; dst = o0 + row * DM + n; } else if (n < 1280) dst = o1 + row * 256 + (n - 1024); else dst = o2 + row * 256 + (n - 1280);
                *dst = (bf16_t)(cvtpk(v, 0.f) & 0xffffu); }
            else if (MODE == 1 || MODE == 3) { v += bflo((unsigned)hin[row * DM + n]); o0[row * DM + n] = (bf16_t)(cvtpk(v, 0.f) & 0xffffu); }
            else { v = fmaxf(v * rsv, 0.f); v = v * v; o0[row * FF + n] = (bf16_t)(cvtpk(v, 0.f) & 0xffffu); }
        }
    }
}

constexpr int KS_LD = 72, VT_LD = 296, KS_BYTES = 288 * KS_LD * 2;
__device__ __forceinline__ void attn_phase(LAS unsigned char* lds, bf16_t* Q, const bf16_t* Kb, const bf16_t* Vb, const float* sinks, int vcu, int G, int wave_) {
    const int tid_ = fresh_tid(wave_);
    const int tid = tid_, lane = tid & 63, wid = wave_, q = lane & 31, hi = lane >> 5;
    LAS bf16_t* Ks = (LAS bf16_t*)lds; LAS bf16_t* Vt = (LAS bf16_t*)(lds + KS_BYTES);
    const int piq = (q & 0x13) | ((q & 4) << 1) | ((q & 8) >> 1);
#pragma unroll 1
    for (int L = vcu; L < 2052; L += G) {
        const bool meta = L >= 2048;
        int b = 0, kvh, qb = 0;
        if (!meta) { b = L >> 7; kvh = (L >> 5) & 3; qb = L & 31; } else kvh = L - 2048;
        const int t0 = qb * 128;
        __syncthreads();
        for (int i = tid; i < 288 * 8; i += 512) {
            const int kk = i >> 3, ch = i & 7; long row = -1;
            if (kk < 256) { const int s = t0 - 128 + kk; if (!meta && s >= 0) row = (long)b * SEQ + s; } else if (kk < 272) row = MREAL + (kk - 256);
            u32x4 kv = (u32x4){0u, 0u, 0u, 0u}, vv = (u32x4){0u, 0u, 0u, 0u};
            if (row >= 0) { kv = *(const u32x4*)(Kb + row * 256 + kvh * 64 + ch * 8); vv = *(const u32x4*)(Vb + row * 256 + kvh * 64 + ch * 8); }
            *(LAS u32x4*)(Ks + kk * KS_LD + ch * 8) = kv;
            LAS bf16_t* vp = Vt + (ch * 8) * VT_LD + kk;
            vp[0 * VT_LD] = (bf16_t)(vv.x & 0xffffu); vp[1 * VT_LD] = (bf16_t)(vv.x >> 16); vp[2 * VT_LD] = (bf16_t)(vv.y & 0xffffu); vp[3 * VT_LD] = (bf16_t)(vv.y >> 16);
            vp[4 * VT_LD] = (bf16_t)(vv.z & 0xffffu); vp[5 * VT_LD] = (bf16_t)(vv.z >> 16); vp[6 * VT_LD] = (bf16_t)(vv.w & 0xffffu); vp[7 * VT_LD] = (bf16_t)(vv.w >> 16);
        }
        __syncthreads();
        const int hq = kvh * 4 + (wid >> 1);
        const float slope = exp2f(-0.5f * (float)(hq + 1)) * LOG2E, sink = sinks[hq] * LOG2E;
#pragma unroll 1
        for (int it = 0; it < 2; ++it) {
            const int rt = (wid & 1) * 2 + it;
            if (meta && rt != 0) continue;
            const long qrow = meta ? (long)(MREAL + q) : (long)b * SEQ + t0 + 32 * rt + q;
            bf16_t* qp = Q + qrow * DM + hq * 64;
            bf16x8 qf[4];
#pragma unroll
            for (int dk = 0; dk < 4; ++dk) qf[dk] = *(const bf16x8*)(qp + dk * 16 + hi * 8);
            f32x16 S[6];
#pragma unroll
            for (int k6 = 0; k6 < 6; ++k6) { const int kt = (k6 < 5) ? rt + k6 : 8; f32x16 a = {};
                const LAS bf16_t* kp = Ks + (32 * kt + piq) * KS_LD + hi * 8;
#pragma unroll
                for (int dk = 0; dk < 4; ++dk) a = __builtin_amdgcn_mfma_f32_32x32x16_bf16(*(const LAS bf16x8*)(kp + dk * 16), qf[dk], a, 0, 0, 0);
                S[k6] = a; asm volatile("" ::: "memory"); }
            float mx = sink;
            int base = 128 + q - 8 * hi; asm volatile("" : "+v"(base));
            const float fb = (float)base;
            const unsigned lim1 = meta ? 0u : (unsigned)min(128, t0 + 32 * rt + q + 1);
            const int qlim = meta ? q : 15;
#pragma unroll
            for (int k6 = 0; k6 < 6; ++k6)
#pragma unroll
                for (int r = 0; r < 16; ++r) { bool ok; float v;
                    if (k6 < 5) { const int cc = 32 * k6 + (r & 7) + 16 * (r >> 3); const int dist = base - cc; ok = (unsigned)dist < lim1; v = S[k6][r] - slope * (fb - (float)cc); }
                    else { const int kin = (r & 7) + 8 * hi + 16 * (r >> 3); ok = kin <= qlim; v = S[k6][r]; }
                    v = ok ? v : -1e30f; S[k6][r] = v; mx = fmaxf(mx, v); }
            mx = max32(mx);
            float l = 0.f;
#pragma unroll
            for (int k6 = 0; k6 < 6; ++k6)
#pragma unroll
                for (int r = 0; r < 16; ++r) { const float p = __builtin_amdgcn_exp2f(S[k6][r] - mx); S[k6][r] = p; l += p; }
            l = sum32(l); l += __builtin_amdgcn_exp2f(sink - mx);
            f32x16 O[2]; O[0] = f32x16{}; O[1] = f32x16{};
#pragma unroll
            for (int k6 = 0; k6 < 6; ++k6) { const int kt = (k6 < 5) ? rt + k6 : 8;
#pragma unroll
                for (int hf = 0; hf < 2; ++hf) {
                    u32x4 pw; pw.x = cvtpk(S[k6][8 * hf + 0], S[k6][8 * hf + 1]); pw.y = cvtpk(S[k6][8 * hf + 2], S[k6][8 * hf + 3]); pw.z = cvtpk(S[k6][8 * hf + 4], S[k6][8 * hf + 5]); pw.w = cvtpk(S[k6][8 * hf + 6], S[k6][8 * hf + 7]);
                    const bf16x8 pb = __builtin_bit_cast(bf16x8, pw);
#pragma unroll
                    for (int dt = 0; dt < 2; ++dt) { const bf16x8 va = *(const LAS bf16x8*)(Vt + (32 * dt + q) * VT_LD + 32 * kt + 16 * hf + 8 * hi);
                        O[dt] = __builtin_amdgcn_mfma_f32_32x32x16_bf16(va, pb, O[dt], 0, 0, 0); }
                    asm volatile("" ::: "memory"); } }
            const float rl = 1.0f / l;
#pragma unroll
            for (int dt = 0; dt < 2; ++dt)
#pragma unroll
                for (int j = 0; j < 4; ++j) { u32x2 w; w.x = cvtpk(O[dt][4 * j] * rl, O[dt][4 * j + 1] * rl); w.y = cvtpk(O[dt][4 * j + 2] * rl, O[dt][4 * j + 3] * rl);
                    if (!meta || q < 16) *(u32x2*)(qp + 32 * dt + 8 * j + 4 * hi) = w; }
        }
    }
    __syncthreads();
}

#define XB_TMO      128
#define XB_XCNT(j)  (256  + 64 * (j))
#define XB_XSUB(j)  (1280 + 64 * (j))
#define XB_XGEN(j)  (2304 + 64 * (j))
#define XB_TOP      3328
#define XB_TOPGEN   3392
#define XCD_BAR_WORDS 3456
#define XB_SPIN_CAP (1u << 18)
__device__ __forceinline__ unsigned xb_ld(unsigned* p)              { return __hip_atomic_load(p, __ATOMIC_RELAXED, __HIP_MEMORY_SCOPE_AGENT); }
__device__ __forceinline__ unsigned xb_add(unsigned* p, unsigned v) { return __hip_atomic_fetch_add(p, v, __ATOMIC_RELAXED, __HIP_MEMORY_SCOPE_AGENT); }
__device__ __forceinline__ unsigned xb_xcc_id() { return (unsigned)__builtin_amdgcn_s_getreg((3 << 11) | 20) & 0xFu; }
#define XB_SPIN(cond, bar) do { unsigned _sp = 0; while (cond) { __builtin_amdgcn_s_sleep(1); \
    if ((++_sp & 255u) == 0u) { if (xb_ld(&(bar)[XB_TMO])) break; if (_sp > XB_SPIN_CAP) { atomicAdd(&(bar)[XB_TMO], 1u); break; } } } } while (0)
struct XcdBarrier { unsigned* bar; unsigned x; volatile LAS unsigned* st; };
__device__ __forceinline__ XcdBarrier xcd_barrier_post(unsigned* bar, volatile LAS unsigned* st) {
    XcdBarrier b; b.bar = bar; b.x = xb_xcc_id(); b.st = st;
    if (threadIdx.x == 0) (void)xb_add(&bar[XB_XCNT(b.x)], 1u);
    return b;
}
__device__ __forceinline__ void xcd_barrier_complete(unsigned* bar, unsigned x, unsigned& nloc, unsigned& nx) {
    const unsigned G = gridDim.x * gridDim.y * gridDim.z;
    unsigned sum, cnt, mine, sp = 0u;
    for (;;) {
        sum = 0u; cnt = 0u; mine = 0u;
#pragma unroll
        for (unsigned j = 0; j < 16; ++j) { const unsigned c = xb_ld(&bar[XB_XCNT(j)]); sum += c; cnt += (c > 0u) ? 1u : 0u; mine = (j == x) ? c : mine; }
        if (sum == G) break;
        __builtin_amdgcn_s_sleep(1);
        if ((++sp & 255u) == 0u) { if (xb_ld(&bar[XB_TMO])) break; if (sp > XB_SPIN_CAP) { atomicAdd(&bar[XB_TMO], 1u); break; } }
    }
    nloc = mine > 0u ? mine : 1u; nx = cnt > 0u ? cnt : 1u;
}
__device__ __forceinline__ void xcd_barrier(const XcdBarrier& b) {
    asm volatile("s_waitcnt vmcnt(0)" ::: "memory");
    __syncthreads();
    if (threadIdx.x == 0) {
        unsigned* bar = b.bar;
        __builtin_amdgcn_s_waitcnt(0);
        unsigned nloc = b.st[0], nx = b.st[1];
        if (nloc == 0u) { xcd_barrier_complete(bar, b.x, nloc, nx); b.st[0] = nloc; b.st[1] = nx; }
        const unsigned old = xb_add(&bar[XB_XSUB(b.x)], 1u);
        const unsigned gen = old / nloc;
        if (old + 1u == (gen + 1u) * nloc) {
            __builtin_amdgcn_fence(__ATOMIC_RELEASE, "agent");
            asm volatile("s_waitcnt vmcnt(0)" ::: "memory");
            const unsigned og = xb_add(&bar[XB_TOP], 1u);
            const unsigned tg = og / nx;
            if (og + 1u == (tg + 1u) * nx) xb_add(&bar[XB_TOPGEN], 1u);
            else XB_SPIN(xb_ld(&bar[XB_TOPGEN]) == tg, bar);
            __builtin_amdgcn_fence(__ATOMIC_ACQUIRE, "agent");
            xb_add(&bar[XB_XGEN(b.x)], 1u);
            asm volatile("s_waitcnt vmcnt(0)" ::: "memory");
        } else {
            XB_SPIN(xb_ld(&bar[XB_XGEN(b.x)]) == gen, bar);
            __builtin_amdgcn_fence(__ATOMIC_ACQUIRE, "agent");
            asm volatile("s_waitcnt vmcnt(0)" ::: "memory");
        }
    }
    __syncthreads();
}

constexpr int LDS_BYTES = 151552;
#ifndef PHMASK
#define PHMASK 0xFFFF
#endif
#ifndef STAG_UP
#define STAG_UP 0
#endif
#define REP(k) for (int rep_ = 0; rep_ < ((DUPMASK >> (k)) & 1) + 1; ++rep_)
__global__ void __launch_bounds__(512, 2) fwd_kernel(Params P) {
    extern __shared__ __attribute__((aligned(16))) unsigned char lds_raw[];
    LAS unsigned char* lds = (LAS unsigned char*)lds_raw;
    cg::grid_group grid = cg::this_grid();
    const int wave = __builtin_amdgcn_readfirstlane((int)threadIdx.x >> 6);
    const int G = gridDim.x, bx = blockIdx.x;
    const int vcu = (G % 8 == 0) ? (bx % 8) * (G / 8) + bx / 8 : bx;
    const int gw = vcu * 8 + wave, NGW = G * 8;
    unsigned char* ws = P.ws;
#define mkxs() (XS{(LAS u32x4*)(lds + 132096 + wave * 2048), fresh_tid(wave) & 63})
    volatile LAS unsigned* bst = (volatile LAS unsigned*)(lds + 131072);
    if (threadIdx.x < 2) bst[threadIdx.x] = 0u;
    __syncthreads();
    const XcdBarrier xbar = xcd_barrier_post((unsigned*)(ws + WS_CTL), bst);
    bf16_t* Wqkv_t = (bf16_t*)(ws + WS_WQKV); bf16_t* Wo_t = (bf16_t*)(ws + WS_WO); bf16_t* Wup0_t = (bf16_t*)(ws + WS_WUP0); bf16_t* Wdn0_t = (bf16_t*)(ws + WS_WDN0);
    bf16_t* Wglu_t = (bf16_t*)(ws + WS_WGLU); bf16_t* Wup1_t = (bf16_t*)(ws + WS_WUP1); bf16_t* Wdn1_t = (bf16_t*)(ws + WS_WDN1);
    bf16_t* BW1 = (bf16_t*)(ws + WS_BW1); bf16_t* BW2 = (bf16_t*)(ws + WS_BW2); float* A16 = (float*)(ws + WS_A16); bf16_t* UM = (bf16_t*)(ws + WS_UM);
    float* RS0 = (float*)(ws + WS_RS0); float* SS1 = (float*)(ws + WS_SS1); float* SS3 = (float*)(ws + WS_SS3); float* SS4 = (float*)(ws + WS_SS4);
    bf16_t* HA = (bf16_t*)(ws + WS_RA); bf16_t* HB = (bf16_t*)(ws + WS_RB);
    bf16_t* Qb = (bf16_t*)(ws + WS_Q); bf16_t* Kb = (bf16_t*)(ws + WS_K); bf16_t* Vb = (bf16_t*)(ws + WS_V); bf16_t* ACT = (bf16_t*)(ws + WS_ACT);
    bf16_t* UX = (bf16_t*)(ws + WS_UX); float* Sst = (float*)(ws + WS_S); bf16_t* Yb = (bf16_t*)(ws + WS_Y);

    REP(0) if (PHMASK & 1) {
        const int t_ = fresh_tid(wave); const int tid = t_, lane = tid & 63; (void)tid; (void)lane;
        LAS float* scr = (LAS float*)(lds + wave * 16384);
        constexpr int I_QKV = 16 * 48, I_O = 16 * 32, I_UP = 16 * 128, I_DN = 64 * 32, I_GLU = 16 * 64;
        constexpr int NITEMS = I_QKV + I_O + 2 * I_UP + 2 * I_DN + I_GLU;
        for (int it = gw; it < NITEMS; it += NGW) {
            int r = it;
            if (r < I_QKV) { transpose_item(P.wqkv, DM, NQKV, Wqkv_t, P.attn_nw, false, scr, r, lane); continue; } r -= I_QKV;
            if (r < I_O) { transpose_item(P.wo, DM, DM, Wo_t, nullptr, false, scr, r, lane); continue; } r -= I_O;
            if (r < I_UP) { transpose_item(P.wup, DM, FF, Wup0_t, P.mlp_nw, false, scr, r, lane); continue; } r -= I_UP;
            if (r < I_DN) { transpose_item(P.wdn, FF, DM, Wdn0_t, nullptr, false, scr, r, lane); continue; } r -= I_DN;
            if (r < I_GLU) { transpose_item(P.wglu, DM, 2 * DM, Wglu_t, nullptr, true, scr, r, lane); continue; } r -= I_GLU;
            if (r < I_UP) { transpose_item(P.wup + (size_t)DM * FF, DM, FF, Wup1_t, P.mlp_nw + DM, false, scr, r, lane); continue; } r -= I_UP;
            transpose_item(P.wdn + (size_t)FF * DM, FF, DM, Wdn1_t, nullptr, false, scr, r, lane);
        }
        for (int m = gw; m < MREAL + NMETA; m += NGW) {
            unsigned long long* o8 = (unsigned long long*)(HA + (size_t)m * DM) + lane;
            const float* src = (m < MREAL) ? P.x + (size_t)m * DM : P.meta + (size_t)(m - MREAL) * DM;
            const f32x4* xr = (const f32x4*)src + lane; f32x4 v[4]; float s = 0.f;
#pragma unroll
            for (int j = 0; j < 4; ++j) { v[j] = xr[64 * j]; s += (v[j].x * v[j].x + v[j].y * v[j].y) + (v[j].z * v[j].z + v[j].w * v[j].w); }
            s = wave_sum(s);
#pragma unroll
            for (int j = 0; j < 4; ++j) o8[64 * j] = (unsigned long long)cvtpk(v[j].x, v[j].y) | ((unsigned long long)cvtpk(v[j].z, v[j].w) << 32);
            if (lane == 0) RS0[m] = 1.0f / sqrtf(s * (1.0f / DM) + EPS);
        }
        __syncthreads();
        {
            LAS float* AP = (LAS float*)lds;
            LAS float* BB = AP + 17 * 64 * 2;
            LAS float* CC = BB + 64 * 16 * 2;
            LAS float* KT = CC + 16 * 64 * 2;
            for (int item = vcu; item < 256; item += G) {
                const int g = item >> 2, qd = item & 3;
                const float dt = expf(P.logdt[g]);
                for (int idx = tid; idx < 17 * 64; idx += 512) { const int tau = idx >> 6, p = idx & 63;
                    SsmP s; s.lr = fminf(P.lre[g * 64 + p], -1e-4f); s.li = P.lim[g * 64 + p]; s.dt = dt; float ar, ai; cpow(s, (float)tau, ar, ai); AP[idx * 2] = ar; AP[idx * 2 + 1] = ai; }
                for (int idx = tid; idx < 64 * 16; idx += 512) { const int p = idx >> 4;
                    SsmP s; s.lr = fminf(P.lre[g * 64 + p], -1e-4f); s.li = P.lim[g * 64 + p]; s.dt = dt; float cr, ci; ccoef(s, cr, ci);
                    const float br = P.bre[g * 1024 + idx], bi = P.bim[g * 1024 + idx]; BB[idx * 2] = cr * br - ci * bi; BB[idx * 2 + 1] = cr * bi + ci * br; }
                for (int idx = tid; idx < 16 * 64; idx += 512) { CC[idx * 2] = P.cre[g * 1024 + idx]; CC[idx * 2 + 1] = P.cim[g * 1024 + idx]; }
                __syncthreads();
                for (int idx = tid; idx < 4096; idx += 512) { const int tau = idx >> 8, c = (idx >> 4) & 15, cp = idx & 15; float k = 0.f;
                    for (int p = 0; p < 64; ++p) { const float ar = AP[(tau * 64 + p) * 2], ai = AP[(tau * 64 + p) * 2 + 1], br = BB[(p * 16 + cp) * 2], bi = BB[(p * 16 + cp) * 2 + 1];
                        k += CC[(c * 64 + p) * 2] * (ar * br - ai * bi) - CC[(c * 64 + p) * 2 + 1] * (ar * bi + ai * br); }
                    KT[idx] = k; }
                __syncthreads();
                for (int idx = tid; idx < 64 * 32; idx += 512) { const int n = qd * 64 + (idx >> 5), k0 = (idx & 31) * 8, ti = n >> 4, c = n & 15, si = k0 >> 4, cp0 = k0 & 15;
                    u32x4 w = (u32x4){0u, 0u, 0u, 0u};
                    if (si <= ti) { const LAS float* kp = KT + ((ti - si) * 16 + c) * 16 + cp0; w.x = cvtpk(kp[0], kp[1]); w.y = cvtpk(kp[2], kp[3]); w.z = cvtpk(kp[4], kp[5]); w.w = cvtpk(kp[6], kp[7]); }
                    *(u32x4*)(BW2 + ((size_t)g * 256 + n) * UXLD + k0) = w; }
                for (int idx = tid; idx < 64 * 16; idx += 512) { const int n = qd * 64 + (idx >> 4), p0 = (idx & 15) * 4, ti = n >> 4, c = n & 15; unsigned w[4];
#pragma unroll
                    for (int j = 0; j < 4; ++j) { const int p = p0 + j; const float cr = CC[(c * 64 + p) * 2], ci = CC[(c * 64 + p) * 2 + 1], ar = AP[((ti + 1) * 64 + p) * 2], ai = AP[((ti + 1) * 64 + p) * 2 + 1];
                        w[j] = cvtpk(cr * ar - ci * ai, -(cr * ai + ci * ar)); }
                    *(u32x4*)(BW2 + ((size_t)g * 256 + n) * UXLD + 256 + 2 * p0) = (u32x4){w[0], w[1], w[2], w[3]}; }
                for (int idx = tid; idx < 16 * 32; idx += 512) { const int p = qd * 16 + (idx >> 5), k0 = (idx & 31) * 8, si = k0 >> 4, cp0 = k0 & 15;
                    const float ar = AP[((15 - si) * 64 + p) * 2], ai = AP[((15 - si) * 64 + p) * 2 + 1]; float re[8], im[8];
#pragma unroll
                    for (int j = 0; j < 8; ++j) { const float br = BB[(p * 16 + cp0 + j) * 2], bi = BB[(p * 16 + cp0 + j) * 2 + 1]; re[j] = ar * br - ai * bi; im[j] = ar * bi + ai * br; }
                    *(u32x4*)(BW1 + ((size_t)g * 256 + 2 * p) * 256 + k0) = (u32x4){cvtpk(re[0], re[1]), cvtpk(re[2], re[3]), cvtpk(re[4], re[5]), cvtpk(re[6], re[7])};
                    *(u32x4*)(BW1 + ((size_t)g * 256 + 2 * p + 1) * 256 + k0) = (u32x4){cvtpk(im[0], im[1]), cvtpk(im[2], im[3]), cvtpk(im[4], im[5]), cvtpk(im[6], im[7])}; }
                for (int idx = tid; idx < 32 * 32; idx += 512) { const int n = 128 + qd * 32 + (idx >> 5), k0 = (idx & 31) * 8;
                    *(u32x4*)(BW1 + ((size_t)g * 256 + n) * 256 + k0) = (u32x4){0u, 0u, 0u, 0u}; }
                if (qd == 0 && tid < 64) { A16[2 * (g * 64 + tid)] = AP[(16 * 64 + tid) * 2]; A16[2 * (g * 64 + tid) + 1] = AP[(16 * 64 + tid) * 2 + 1]; }
                __syncthreads();
            }
        }
    }
    grid.sync();

    REP(1) if (PHMASK & (1 << 1)) {
        pg8::Gemm g{HA, Wqkv_t, DM, DM, DM, 0, 0}; pg8::StaticOrder S; S.init(MREAL, NQKV, G, bx);
        EpiQKV E{Qb, Kb, Vb, RS0, 0.125f * LOG2E, mkxs()};
        pg8::gemm_phase(lds, g, S, E, wave);
        { const int t_ = fresh_tid(wave); meta_gemm<0>(HA + (size_t)MREAL * DM, DM, Wqkv_t, NQKV, DM, gw, NGW, t_ & 63, RS0, Qb, Kb, Vb, nullptr); }
    }
    xcd_barrier(xbar);
    if (PHMASK & 4) attn_phase(lds, Qb, Kb, Vb, P.sinks, vcu, G, wave);
    xcd_barrier(xbar);
    REP(3) if (PHMASK & (1 << 3)) {
        pg8::Gemm g{Qb, Wo_t, DM, DM, DM, 0, 0}; pg8::StaticOrder S; S.init(MREAL, DM, G, bx);
        EpiResid E{HA, HB, SS1, mkxs()};
        pg8::gemm_phase(lds, g, S, E, wave);
        { const int t_ = fresh_tid(wave); meta_gemm<1>(Qb + (size_t)MREAL * DM, DM, Wo_t, DM, DM, gw, NGW, t_ & 63, nullptr, HB, nullptr, nullptr, HA); }
    }
    xcd_barrier(xbar);
    REP(4) if (PHMASK & (1 << 4)) {
        pg8::Gemm g{HB, Wup0_t, DM, DM, DM, 0, 0}; pg8::StaticOrder S; S.init(MREAL, FF, G, bx);
        EpiUp<16> E{SS1, ACT, mkxs()};
        pg8::gemm_phase(lds, g, S, E, wave, STAG_UP);
        { const int t_ = fresh_tid(wave); meta_gemm<2>(HB + (size_t)MREAL * DM, DM, Wup0_t, FF, DM, gw, NGW, t_ & 63, nullptr, ACT, nullptr, nullptr, nullptr); }
    }
    xcd_barrier(xbar);
    REP(5) if (PHMASK & (1 << 5)) {
        pg8::Gemm g{ACT, Wdn0_t, FF, FF, FF, 0, 0}; pg8::StaticOrder S; S.init(MREAL, DM, G, bx);
        EpiResid E{HB, HA, nullptr, mkxs()};
        pg8::gemm_phase(lds, g, S, E, wave);
        { const int t_ = fresh_tid(wave); meta_gemm<3>(ACT + (size_t)MREAL * FF, FF, Wdn0_t, DM, FF, gw, NGW, t_ & 63, nullptr, HA, nullptr, nullptr, HB); }
    }
    xcd_barrier(xbar);
    REP(6) if (PHMASK & (1 << 6)) {
        const int t_ = fresh_tid(wave); const int tid = t_, lane = tid & 63; (void)tid; (void)lane;
        f32x4 wv[4];
#pragma unroll
        for (int j = 0; j < 4; ++j) wv[j] = *(const f32x4*)(P.ssm_nw + lane * 16 + 4 * j);
        for (int ch = gw; ch < NCH + 1; ch += NGW) {
            const bool mt = ch == NCH;
            for (int ti = 0; ti < 16; ++ti) {
                const size_t row = mt ? (size_t)(MREAL + ti) : (size_t)ch * 16 + ti;
                const u32x4* hp = (const u32x4*)(HA + row * DM + lane * 16);
                f32x4 v[4]; unpack8(hp[0], v[0], v[1]); unpack8(hp[1], v[2], v[3]);
                float s = 0.f;
#pragma unroll
                for (int j = 0; j < 4; ++j) s += (v[j].x * v[j].x + v[j].y * v[j].y) + (v[j].z * v[j].z + v[j].w * v[j].w);
                s = wave_sum(s); const float rs = 1.0f / sqrtf(s * (1.0f / DM) + EPS);
#pragma unroll
                for (int j = 0; j < 4; ++j) v[j] = v[j] * rs * wv[j];
                bf16_t* dst = mt ? UM + lane * 256 + ti * 16 : UX + ((size_t)lane * NCH + ch) * UXLD + ti * 16;
                *(u32x4*)dst = pack8(v[0], v[1]); *(u32x4*)(dst + 8) = pack8(v[2], v[3]);
            }
        }
    }
    xcd_barrier(xbar);
    REP(7) if (PHMASK & (1 << 7)) {
        pg8::Gemm g{UX, BW1, 256, UXLD, 256, (size_t)NCH * UXLD, (size_t)256 * 256}; pg8::BatchOrder S{G, bx};
        EpiS E{Sst};
        pg8::gemm_phase(lds, g, S, E, wave);
    }
    xcd_barrier(xbar);
    REP(8) if (PHMASK & 256) {
        const int t_ = fresh_tid(wave); const int tid = t_, lane = tid & 63; (void)tid; (void)lane;
      if (tid < 256) {
        const int item = bx * 256 + tid;
        if (item < NB * 64 * 64) {
            const int p = item & 63, g = (item >> 6) & 63, b = item >> 12;
            const float ar = A16[2 * (g * 64 + p)], ai = A16[2 * (g * 64 + p) + 1];
            float xr = 0.f, xi = 0.f;
            { const bf16_t* um = UM + g * 256; const bf16_t* w0 = BW1 + ((size_t)g * 256 + 2 * p) * 256; const bf16_t* w1 = w0 + 256;
                for (int k = 0; k < 256; k += 8) { f32x4 u0, u1, a0, a1, b0, b1; unpack8(*(const u32x4*)(um + k), u0, u1); unpack8(*(const u32x4*)(w0 + k), a0, a1); unpack8(*(const u32x4*)(w1 + k), b0, b1);
#pragma unroll
                    for (int i = 0; i < 4; ++i) { xr += u0[i] * a0[i] + u1[i] * a1[i]; xi += u0[i] * b0[i] + u1[i] * b1[i]; } } }
            const float* sp = Sst + ((size_t)g * NCH + b * 256) * 128 + 2 * p;
            bf16_t* xp = UX + ((size_t)g * NCH + b * 256) * UXLD + 256 + 2 * p;
            for (int j0 = 0; j0 < 256; j0 += 16) {
                f32x2_t sv[16];
#pragma unroll
                for (int j = 0; j < 16; ++j) sv[j] = *(const f32x2_t*)(sp + (size_t)(j0 + j) * 128);
#pragma unroll
                for (int j = 0; j < 16; ++j) { *(unsigned*)(xp + (size_t)(j0 + j) * UXLD) = cvtpk(xr, xi);
                    const float nr = ar * xr - ai * xi + sv[j].x, ni = ar * xi + ai * xr + sv[j].y; xr = nr; xi = ni; }
            }
        }
      }
    }
    xcd_barrier(xbar);
    REP(9) if (PHMASK & (1 << 9)) {
        pg8::Gemm g{UX, BW2, UXLD, UXLD, UXLD, (size_t)NCH * UXLD, (size_t)256 * UXLD}; pg8::BatchOrder S{G, bx};
        EpiY E{UX, P.dsk, Yb, mkxs()};
        pg8::gemm_phase(lds, g, S, E, wave);
    }
    xcd_barrier(xbar);
    REP(10) if (PHMASK & (1 << 10)) {
        pg8::Gemm g{Yb, Wglu_t, DM, DM, DM, 0, 0}; pg8::StaticOrder S; S.init(MREAL, 2 * DM, G, bx);
        EpiGLU E{HA, HB, SS3, mkxs()};
        pg8::gemm_phase(lds, g, S, E, wave);
    }
    xcd_barrier(xbar);
    REP(11) if (PHMASK & (1 << 11)) {
        pg8::Gemm g{HB, Wup1_t, DM, DM, DM, 0, 0}; pg8::StaticOrder S; S.init(MREAL, FF, G, bx);
        EpiUp<32> E{SS3, ACT, mkxs()};
        pg8::gemm_phase(lds, g, S, E, wave, STAG_UP);
    }
    xcd_barrier(xbar);
    REP(12) if (PHMASK & (1 << 12)) {
        pg8::Gemm g{ACT, Wdn1_t, FF, FF, FF, 0, 0}; pg8::StaticOrder S; S.init(MREAL, DM, G, bx);
        EpiResid E{HB, HA, SS4, mkxs()};
        pg8::gemm_phase(lds, g, S, E, wave);
    }
    xcd_barrier(xbar);
    for (int xs_ = 0; xs_ < XSYNC; ++xs_) xcd_barrier(xbar);
    REP(13) if (PHMASK & (1 << 13)) {
        const int t_ = fresh_tid(wave); const int tid = t_, lane = tid & 63; (void)tid; (void)lane;
      for (int m = gw; m < MREAL; m += NGW) {
        const float sl = (lane < 16) ? SS4[(size_t)m * 16 + lane] : 0.f;
        const float rs = 1.0f / sqrtf(wave_sum(sl) * (1.0f / DM) + EPS);
        const u32x4* hp = (const u32x4*)(HA + (size_t)m * DM);
        f32x4* op = (f32x4*)(P.out + (size_t)m * DM);
#pragma unroll
        for (int j = 0; j < 2; ++j) { f32x4 v0, v1; unpack8(hp[64 * j + lane], v0, v1);
            const f32x4 w0 = *(const f32x4*)(P.fnw + (64 * j + lane) * 8), w1 = *(const f32x4*)(P.fnw + (64 * j + lane) * 8 + 4);
            op[(64 * j + lane) * 2] = v0 * rs * w0; op[(64 * j + lane) * 2 + 1] = v1 * rs * w1; }
      }
    }
}

extern "C" void kernel_launch(void* const* d_in, const int* in_sizes, int n_in, void* d_out, int out_size, void* d_ws, size_t ws_size, hipStream_t stream) {
    static int grid = 0;
    if (grid == 0) {
        if (n_in != 20 || ws_size < WS_END) { fprintf(stderr, "kernel_launch: unexpected n_in %d or ws_size %zu (need %zu)\n", n_in, ws_size, (size_t)WS_END); grid = -1; return; }
        int dev = 0, cus = 0, per_cu = 0;
        hipGetDevice(&dev); hipDeviceGetAttribute(&cus, hipDeviceAttributeMultiprocessorCount, dev);
        hipFuncSetAttribute((const void*)fwd_kernel, hipFuncAttributeMaxDynamicSharedMemorySize, LDS_BYTES);
        hipOccupancyMaxActiveBlocksPerMultiprocessor(&per_cu, (const void*)fwd_kernel, 512, LDS_BYTES);
        if (per_cu < 1) { fprintf(stderr, "kernel_launch: occupancy query says %d blocks/CU\n", per_cu); per_cu = 1; }
        (void)hipGetLastError();
        grid = cus;
    }
    if (grid < 0) return;
    Params p{};
    p.x = (const float*)d_in[0]; p.meta = (const float*)d_in[1]; p.attn_nw = (const float*)d_in[2]; p.wqkv = (const float*)d_in[3]; p.sinks = (const float*)d_in[4]; p.wo = (const float*)d_in[5];
    p.ssm_nw = (const float*)d_in[6]; p.lre = (const float*)d_in[7]; p.lim = (const float*)d_in[8]; p.logdt = (const float*)d_in[9]; p.bre = (const float*)d_in[10]; p.bim = (const float*)d_in[11];
    p.cre = (const float*)d_in[12]; p.cim = (const float*)d_in[13]; p.dsk = (const float*)d_in[14]; p.wglu = (const float*)d_in[15]; p.mlp_nw = (const float*)d_in[16]; p.wup = (const float*)d_in[17];
    p.wdn = (const float*)d_in[18]; p.fnw = (const float*)d_in[19]; p.out = (float*)d_out; p.ws = (unsigned char*)d_ws;
    if (hipMemsetAsync((char*)d_ws + WS_CTL, 0, XCD_BAR_WORDS * 4, stream) != hipSuccess) { fprintf(stderr, "kernel_launch: memset failed\n"); return; }
    void* args[] = {&p};
    hipError_t e = hipLaunchCooperativeKernel((const void*)fwd_kernel, dim3(grid), dim3(512), args, LDS_BYTES, stream);
    if (e != hipSuccess) fprintf(stderr, "cooperative launch failed: %s (grid %d)\n", hipGetErrorString(e), grid);
}
```

```cpp
#include <hip/hip_runtime.h>
#include <hip/hip_cooperative_groups.h>
#include <cstdio>
#include <cstdint>
namespace cg = cooperative_groups;
#ifndef EPI2
#define EPI2 0
#endif
#ifndef DUPMASK
#define DUPMASK 0
#endif
#ifndef XSYNC
#define XSYNC 0
#endif

#define LAS __attribute__((address_space(3)))
typedef unsigned short bf16_t;
typedef short bf16x8 __attribute__((ext_vector_type(8)));
typedef float f32x4 __attribute__((ext_vector_type(4)));
typedef float f32x16 __attribute__((ext_vector_type(16)));
typedef unsigned u32x4 __attribute__((ext_vector_type(4)));
typedef unsigned u32x2 __attribute__((ext_vector_type(2)));
typedef float f32x2_t __attribute__((ext_vector_type(2)));
typedef __bf16 bf16x2_t __attribute__((ext_vector_type(2)));

__device__ __forceinline__ unsigned cvtpk(float lo, float hi) { f32x2_t v = {lo, hi}; bf16x2_t b = __builtin_convertvector(v, bf16x2_t); return __builtin_bit_cast(unsigned, b); }
__device__ __forceinline__ float bflo(unsigned w) { return __uint_as_float(w << 16); }
__device__ __forceinline__ float bfhi(unsigned w) { return __uint_as_float(w & 0xffff0000u); }

__device__ __forceinline__ int fresh_tid(int wave) { int l; asm volatile("v_mbcnt_lo_u32_b32 %0, -1, 0\n\tv_mbcnt_hi_u32_b32 %0, -1, %0" : "=v"(l)); return wave * 64 + l; }
template <int X> __device__ __forceinline__ float xshfl(float v) {
    if (X == 32) { auto rr = __builtin_amdgcn_permlane32_swap(__float_as_uint(v), __float_as_uint(v), false, false);
        const int l = __builtin_amdgcn_mbcnt_lo(~0u, 0u); (void)l; return 0.f; }
    return __uint_as_float((unsigned)__builtin_amdgcn_ds_swizzle((int)__float_as_uint(v), (X << 10) | 0x1f));
}
__device__ __forceinline__ float sum32(float v) { auto rr = __builtin_amdgcn_permlane32_swap(__float_as_uint(v), __float_as_uint(v), false, false); return __uint_as_float(rr[0]) + __uint_as_float(rr[1]); }
__device__ __forceinline__ float max32(float v) { auto rr = __builtin_amdgcn_permlane32_swap(__float_as_uint(v), __float_as_uint(v), false, false); return fmaxf(__uint_as_float(rr[0]), __uint_as_float(rr[1])); }

constexpr int DM = 1024, NB = 16, SEQ = 4096, NMETA = 16, FF = 4096;
constexpr int MREAL = NB * SEQ;
constexpr int MALL = MREAL + 256;
constexpr int NQKV = 1536;
constexpr float EPS = 1e-6f;
constexpr float LOG2E = 1.4426950408889634f;
constexpr int NCH = MREAL / 16;
constexpr int UXLD = 384;

constexpr size_t MiB = 1u << 20;
constexpr size_t WS_WQKV = 0, WS_WO = 3 * MiB, WS_WUP0 = 5 * MiB, WS_WDN0 = 13 * MiB, WS_WGLU = 21 * MiB, WS_WUP1 = 25 * MiB, WS_WDN1 = 33 * MiB;
constexpr size_t WS_BW1 = 41 * MiB, WS_BW2 = 49 * MiB, WS_A16 = 61 * MiB, WS_UM = 61 * MiB + 65536, WS_RS0 = 62 * MiB;
constexpr size_t WS_SS1 = 63 * MiB, WS_SS3 = 68 * MiB, WS_SS4 = 76 * MiB;
constexpr size_t WS_CTL = 81 * MiB;
constexpr size_t WS_RA = 82 * MiB, WS_RB = 211 * MiB, WS_RC = 340 * MiB;
constexpr size_t WS_Q = WS_RC, WS_K = WS_RC + 129 * MiB, WS_V = WS_RC + 162 * MiB;
constexpr size_t WS_ACT = WS_RC;
constexpr size_t WS_UX = WS_RC, WS_S = WS_RC + 192 * MiB, WS_Y = WS_RC + 320 * MiB;
constexpr size_t WS_END = WS_RC + 514 * MiB;

namespace pg8 {
constexpr int BM = 256, BK = 64, HALF = 128, HTB = HALF * BK * 2, STAGE_BYTES = 8 * HTB, NXCD = 8, WGM = 8;
__host__ __device__ __forceinline__ int lds_byte(int r, int c) { const int st = (r >> 4) * 2 + (c >> 5), rr = r & 15, cc = c & 31, ob = rr * 64 + cc * 2; return st * 1024 + (ob ^ (((ob >> 9) & 1) << 5)); }
__host__ __device__ __forceinline__ void stage_rc(int b, int& R, int& C) { const int st = b / 1024, sb = b % 1024, swz = sb ^ (((sb >> 9) & 1) << 5); R = (st >> 1) * 16 + swz / 64; C = (st & 1) * 32 + (swz % 64) / 2; }
__host__ __device__ __forceinline__ int perm32(int rho) { const int n = rho >> 4, i = rho & 15; return 8 * (i >> 2) + 4 * n + (i & 3); }

struct Unit { int pm, pn, pb; };
struct Gemm { const bf16_t* A; const bf16_t* Bt; int K, lda, ldb; size_t bsA, bsB; };

struct StaticOrder {
    int nM, nN, nwg, G, c;
    __device__ void init(int M, int N, int G_, int c_) { nM = M / BM; nN = N / BM; nwg = nM * nN; G = G_; c = c_; }
    __device__ bool next(int i, Unit& u) const {
        const long L = (long)i * G + c; if (L >= nwg) return false;
        int wgid = (int)L; { const int q = nwg / NXCD, r = nwg % NXCD, xcd = wgid % NXCD, off = wgid / NXCD; wgid = (xcd < r ? xcd * (q + 1) : r * (q + 1) + (xcd - r) * q) + off; }
        const int nig = WGM * nN, gid = wgid / nig, fm = gid * WGM, gsz = (nM - fm) < WGM ? (nM - fm) : WGM;
        u.pm = fm + ((wgid % nig) % gsz); u.pn = (wgid % nig) / gsz; u.pb = 0; return true;
    }
};
struct BatchOrder {
    int G, c;
    __device__ bool next(int i, Unit& u) const { const int L = i * G + c; if (L >= 64 * 16) return false; u.pb = L >> 4; u.pm = L & 15; u.pn = 0; return true; }
};

template <class Epi, class Sched>
__device__ __forceinline__ void gemm_phase(LAS unsigned char* lds, const Gemm g, const Sched& S, const Epi& E, int wave_, unsigned stag = 0) {
    if (stag > 7u) { const unsigned long long t0_ = __builtin_amdgcn_s_memrealtime(); const unsigned long long w_ = (unsigned long long)(blockIdx.x >> 3) * stag / 32;
        while (__builtin_amdgcn_s_memrealtime() - t0_ < w_) __builtin_amdgcn_s_sleep(8); }
    const int tid_ = fresh_tid(wave_);
    const int tid = tid_, wid = wave_, lane = tid & 63, wr = wid >> 2, wc = wid & 3, fr = lane & 15, fq = lane >> 4;
    const int K = g.K, nt = K / BK;
    unsigned voffA[2], voffB[2];
#pragma unroll
    for (int i = 0; i < 2; ++i) { int R, C; stage_rc(tid * 16 + i * 8192, R, C); const int Rb = (R & ~31) + perm32(R & 31);
        voffA[i] = (unsigned)(R * g.lda + C) * 2u; voffB[i] = (unsigned)(Rb * g.ldb + C) * 2u; }
    const size_t kstep = (size_t)(BK * 2);
    const size_t hA = (size_t)HALF * g.lda * 2, hB = (size_t)HALF * g.ldb * 2;
    const size_t tA = 2 * hA, tB = 2 * hB;
    const unsigned ldsw = (unsigned)wid * 1024u;
    const int aoff = lds_byte(wr * 64 + fr, fq * 8), boff = lds_byte(wc * 32 + fr, fq * 8);
#define PG8_SA(b, h) (((b) * 2 + (h)) * HTB)
#define PG8_SB(b, h) ((4 + (b) * 2 + (h)) * HTB)
#define PG8_STAGE(bufoff, gbase, voff) do { _Pragma("unroll") for (int _i = 0; _i < 2; ++_i) \
        __builtin_amdgcn_global_load_lds((const unsigned*)((const char*)(gbase) + (voff)[_i]), (LAS unsigned*)(lds + (bufoff) + ldsw + _i * 8192), 16, 0, 0); } while (0)
#define PG8_LDA(dst, b, h) do { _Pragma("unroll") for (int m = 0; m < 4; ++m) _Pragma("unroll") for (int k = 0; k < 2; ++k) dst[m][k] = *(const LAS bf16x8*)(lds + PG8_SA(b, h) + aoff + m * 2048 + k * 1024); } while (0)
#define PG8_LDB(dst, b, h) do { _Pragma("unroll") for (int n = 0; n < 2; ++n) _Pragma("unroll") for (int k = 0; k < 2; ++k) dst[n][k] = *(const LAS bf16x8*)(lds + PG8_SB(b, h) + boff + n * 2048 + k * 1024); } while (0)
#define PG8_MMA(ai, bj, At, Bt) do { __builtin_amdgcn_s_setprio(1); _Pragma("unroll") for (int m = 0; m < 4; ++m) _Pragma("unroll") for (int n = 0; n < 2; ++n) _Pragma("unroll") for (int k = 0; k < 2; ++k) \
        acc[ai][bj][m][n] = __builtin_amdgcn_mfma_f32_16x16x32_bf16(Bt[n][k], At[m][k], acc[ai][bj][m][n], 0, 0, 0); __builtin_amdgcn_s_setprio(0); } while (0)
#define PG8_WAIT_V(n) asm volatile("s_waitcnt vmcnt(" #n ")" ::: "memory")
#define PG8_WAIT_L(n) asm volatile("s_waitcnt lgkmcnt(" #n ")" ::: "memory")
#define PG8_BAR __builtin_amdgcn_s_barrier()
#define PG8_SCHED __builtin_amdgcn_sched_barrier(0)
    Unit cur, nxt; int ui = 0;
    if (!S.next(0, cur)) return;
    f32x4 acc[2][2][4][2];
#pragma unroll
    for (int a = 0; a < 2; ++a)
#pragma unroll
        for (int b = 0; b < 2; ++b)
#pragma unroll
            for (int m = 0; m < 4; ++m)
#pragma unroll
                for (int n = 0; n < 2; ++n) acc[a][b][m][n] = (f32x4){0.f, 0.f, 0.f, 0.f};
    bf16x8 At[4][2], B0[2][2], B1[2][2];
    const char* cA = (const char*)g.A + (size_t)cur.pb * g.bsA * 2 + (size_t)cur.pm * tA;
    const char* cB = (const char*)g.Bt + (size_t)cur.pb * g.bsB * 2 + (size_t)cur.pn * tB;
    PG8_STAGE(PG8_SB(0, 0), cB, voffB); PG8_STAGE(PG8_SB(0, 1), cB + hB, voffB); PG8_STAGE(PG8_SA(0, 0), cA, voffA); PG8_STAGE(PG8_SA(0, 1), cA + hA, voffA);
    if (wr == 1) PG8_BAR;
    PG8_WAIT_V(2); PG8_BAR;
    PG8_STAGE(PG8_SB(1, 0), cB + kstep, voffB); PG8_STAGE(PG8_SA(1, 0), cA + kstep, voffA); PG8_STAGE(PG8_SB(1, 1), cB + hB + kstep, voffB);
    PG8_WAIT_V(6); PG8_BAR;
    for (;;) {
        const bool has_next = S.next(ui + 1, nxt);
        const char* nA = has_next ? (const char*)g.A + (size_t)nxt.pb * g.bsA * 2 + (size_t)nxt.pm * tA : cA;
        const char* nB = has_next ? (const char*)g.Bt + (size_t)nxt.pb * g.bsB * 2 + (size_t)nxt.pn * tB : cB;
#pragma unroll 1
        for (int t = 0; t < nt; t += 2) {
            const bool last = (t == nt - 2);
            const char* a1 = cA + (size_t)(t + 1) * kstep;
            const char* a2 = last ? nA : cA + (size_t)(t + 2) * kstep; const char* b2 = last ? nB : cB + (size_t)(t + 2) * kstep;
            const char* a3 = a2 + kstep; const char* b3 = b2 + kstep;
            PG8_LDB(B0, 0, 0); PG8_LDB(B1, 0, 1); PG8_SCHED; PG8_LDA(At, 0, 0); PG8_STAGE(PG8_SA(1, 1), a1 + hA, voffA);
            PG8_WAIT_V(8); PG8_WAIT_L(0); PG8_BAR; PG8_MMA(0, 0, At, B0); PG8_MMA(0, 1, At, B1); PG8_BAR; PG8_SCHED;
            PG8_LDA(At, 0, 1); PG8_STAGE(PG8_SB(0, 0), b2, voffB); PG8_STAGE(PG8_SB(0, 1), b2 + hB, voffB); PG8_STAGE(PG8_SA(0, 0), a2, voffA);
            PG8_WAIT_V(8); PG8_WAIT_L(0); PG8_BAR; PG8_MMA(1, 0, At, B0); PG8_MMA(1, 1, At, B1); PG8_BAR; PG8_SCHED;
            PG8_LDB(B0, 1, 0); PG8_LDB(B1, 1, 1); PG8_SCHED; PG8_LDA(At, 1, 0); PG8_STAGE(PG8_SA(0, 1), a2 + hA, voffA);
            PG8_WAIT_V(8); PG8_WAIT_L(0); PG8_BAR; PG8_MMA(0, 0, At, B0); PG8_MMA(0, 1, At, B1); PG8_BAR; PG8_SCHED;
            PG8_LDA(At, 1, 1); PG8_STAGE(PG8_SB(1, 0), b3, voffB); PG8_STAGE(PG8_SB(1, 1), b3 + hB, voffB); PG8_STAGE(PG8_SA(1, 0), a3, voffA);
            PG8_WAIT_V(8); PG8_WAIT_L(0); PG8_BAR; PG8_MMA(1, 0, At, B0); PG8_MMA(1, 1, At, B1); PG8_BAR; PG8_SCHED;
        }
        if (wr == 0) PG8_BAR;
        E(acc, cur, wr, wc, fr, fq);
        if (EPI2 && stag == 7u) { asm volatile("" ::: "memory"); E(acc, cur, wr, wc, fr, fq); }
        if (!has_next) break;
#pragma unroll
        for (int a = 0; a < 2; ++a)
#pragma unroll
            for (int b = 0; b < 2; ++b)
#pragma unroll
                for (int m = 0; m < 4; ++m)
#pragma unroll
                    for (int n = 0; n < 2; ++n) acc[a][b][m][n] = (f32x4){0.f, 0.f, 0.f, 0.f};
        cur = nxt; cA = nA; cB = nB; ++ui;
        if (wr == 1) PG8_BAR;
    }
    PG8_WAIT_V(0);
    PG8_BAR;
#undef PG8_SA
#undef PG8_SB
#undef PG8_STAGE
#undef PG8_LDA
#undef PG8_LDB
#undef PG8_MMA
#undef PG8_WAIT_V
#undef PG8_WAIT_L
#undef PG8_BAR
#undef PG8_SCHED
}
}
using pg8::Unit;
typedef f32x4 AccT[2][2][4][2];
__device__ __forceinline__ float wave_sum(float v) {
    v += xshfl<1>(v); v += xshfl<2>(v); v += xshfl<4>(v); v += xshfl<8>(v); v += xshfl<16>(v); return sum32(v);
}


__device__ __forceinline__ u32x4 pack8(f32x4 v0, f32x4 v1) { u32x4 w; w.x = cvtpk(v0[0], v0[1]); w.y = cvtpk(v0[2], v0[3]); w.z = cvtpk(v1[0], v1[1]); w.w = cvtpk(v1[2], v1[3]); return w; }
__device__ __forceinline__ void unpack8(u32x4 w, f32x4& v0, f32x4& v1) { v0 = (f32x4){bflo(w.x), bfhi(w.x), bflo(w.y), bfhi(w.y)}; v1 = (f32x4){bflo(w.z), bfhi(w.z), bflo(w.w), bfhi(w.w)}; }

template <int NS> __device__ __forceinline__ float row_rs(const float* SS, int r, int fq) {
    float s;
    if (NS == 16) { const f32x4 a = *(const f32x4*)(SS + (size_t)r * 16 + fq * 4); s = (a[0] + a[1]) + (a[2] + a[3]); }
    else { const f32x4 a = *(const f32x4*)(SS + (size_t)r * 32 + fq * 8), b = *(const f32x4*)(SS + (size_t)r * 32 + fq * 8 + 4); s = ((a[0] + a[1]) + (a[2] + a[3])) + ((b[0] + b[1]) + (b[2] + b[3])); }
    s += xshfl<16>(s); s = sum32(s);
    return __builtin_amdgcn_rsqf(s * (1.0f / DM) + EPS);
}

struct XS { LAS u32x4* p; int lane; };
__device__ __forceinline__ void lane_tr2(const XS& x, int fr, int fq, u32x4& w0, u32x4& w1) {
    x.p[fr * 4 + fq] = w0; x.p[64 + fr * 4 + fq] = w1;
    w0 = x.p[x.lane]; w1 = x.p[64 + x.lane];
}
__device__ __forceinline__ void lane_tr1(const XS& x, int fr, int fq, u32x4& w0) { x.p[fr * 4 + fq] = w0; w0 = x.p[x.lane]; }
struct EpiQKV {
    bf16_t* Q; bf16_t* Kb; bf16_t* Vb; const float* rs; float qscale; XS xs;
    __device__ __forceinline__ void operator()(const AccT& acc, const Unit& u, int wr, int wc, int fr, int fq) const {
        const int row0 = u.pm * 256 + wr * 64 + fr;
        bf16_t* base; int ld, cb; float sc;
        if (u.pn < 4) { base = Q; ld = DM; cb = u.pn * 256; sc = qscale; } else if (u.pn == 4) { base = Kb; ld = 256; cb = 0; sc = 1.f; } else { base = Vb; ld = 256; cb = 0; sc = 1.f; }
        const int col0 = cb + wc * 32 + 8 * fq;
        float s[2][4];
#pragma unroll
        for (int ai = 0; ai < 2; ++ai)
#pragma unroll
            for (int m = 0; m < 4; ++m) s[ai][m] = rs[row0 + ai * 128 + m * 16] * sc;
        asm volatile("" ::: "memory");
#pragma unroll
        for (int ai = 0; ai < 2; ++ai)
#pragma unroll
            for (int m = 0; m < 4; ++m) { const int r = row0 - fr + (xs.lane >> 2) + ai * 128 + m * 16; bf16_t* rowp = base + (size_t)r * ld + cb + wc * 32 + 8 * (xs.lane & 3);
                u32x4 w0 = pack8(acc[ai][0][m][0] * s[ai][m], acc[ai][0][m][1] * s[ai][m]), w1 = pack8(acc[ai][1][m][0] * s[ai][m], acc[ai][1][m][1] * s[ai][m]);
                lane_tr2(xs, fr, fq, w0, w1); *(u32x4*)rowp = w0; *(u32x4*)(rowp + 128) = w1; }
    }
};
struct EpiResid {
    const bf16_t* Hin; bf16_t* Hout; float* SS; XS xs;
    __device__ __forceinline__ void operator()(const AccT& acc, const Unit& u, int wr, int wc, int fr, int fq) const {
        const int row0 = u.pm * 256 + wr * 64 + fr, col0 = u.pn * 256 + wc * 32 + 8 * fq;
        u32x4 hr[2][4][2];
#pragma unroll
        for (int ai = 0; ai < 2; ++ai)
#pragma unroll
            for (int m = 0; m < 4; ++m)
#pragma unroll
                for (int bj = 0; bj < 2; ++bj) hr[ai][m][bj] = *(const u32x4*)(Hin + (size_t)(row0 + ai * 128 + m * 16) * DM + col0 + bj * 128);
        asm volatile("" ::: "memory");
#pragma unroll
        for (int ai = 0; ai < 2; ++ai)
#pragma unroll
            for (int m = 0; m < 4; ++m) { const int r = row0 + ai * 128 + m * 16; float q = 0.f; u32x4 wv[2];
#pragma unroll
                for (int bj = 0; bj < 2; ++bj) { f32x4 h0, h1; unpack8(hr[ai][m][bj], h0, h1);
                    const f32x4 v0 = acc[ai][bj][m][0] + h0, v1 = acc[ai][bj][m][1] + h1;
                    q += (v0[0] * v0[0] + v0[1] * v0[1]) + (v0[2] * v0[2] + v0[3] * v0[3]) + (v1[0] * v1[0] + v1[1] * v1[1]) + (v1[2] * v1[2] + v1[3] * v1[3]);
                    wv[bj] = pack8(v0, v1); }
                lane_tr2(xs, fr, fq, wv[0], wv[1]);
                { bf16_t* op = Hout + (size_t)(r - fr + (xs.lane >> 2)) * DM + u.pn * 256 + wc * 32 + 8 * (xs.lane & 3); *(u32x4*)op = wv[0]; *(u32x4*)(op + 128) = wv[1]; }
                if (SS) { q += xshfl<16>(q); q = sum32(q); if (fq == 0) SS[(size_t)r * 16 + u.pn * 4 + wc] = q; } }
    }
};
template <int NS> struct EpiUp {
    const float* SS; bf16_t* ACT; XS xs;
    __device__ __forceinline__ void operator()(const AccT& acc, const Unit& u, int wr, int wc, int fr, int fq) const {
        const int row0 = u.pm * 256 + wr * 64 + fr, col0 = u.pn * 256 + wc * 32 + 8 * fq;
        float s[2][4];
#pragma unroll
        for (int ai = 0; ai < 2; ++ai)
#pragma unroll
            for (int m = 0; m < 4; ++m) { const int r = row0 + ai * 128 + m * 16;
                if (NS == 16) { const f32x4 a = *(const f32x4*)(SS + (size_t)r * 16 + fq * 4); s[ai][m] = (a[0] + a[1]) + (a[2] + a[3]); }
                else { const f32x4 a = *(const f32x4*)(SS + (size_t)r * 32 + fq * 8), b = *(const f32x4*)(SS + (size_t)r * 32 + fq * 8 + 4); s[ai][m] = ((a[0] + a[1]) + (a[2] + a[3])) + ((b[0] + b[1]) + (b[2] + b[3])); } }
        asm volatile("" ::: "memory");
#pragma unroll
        for (int ai = 0; ai < 2; ++ai)
#pragma unroll
            for (int m = 0; m < 4; ++m) { float t = s[ai][m]; t += xshfl<16>(t); t = sum32(t); s[ai][m] = __builtin_amdgcn_rsqf(t * (1.0f / DM) + EPS); }
#pragma unroll
        for (int ai = 0; ai < 2; ++ai)
#pragma unroll
            for (int m = 0; m < 4; ++m) { const int r = row0 - fr + (xs.lane >> 2) + ai * 128 + m * 16; const float sc = s[ai][m]; bf16_t* rowp = ACT + (size_t)r * FF + u.pn * 256 + wc * 32 + 8 * (xs.lane & 3); u32x4 wv[2];
#pragma unroll
                for (int bj = 0; bj < 2; ++bj) { f32x4 v0 = acc[ai][bj][m][0] * sc, v1 = acc[ai][bj][m][1] * sc;
#pragma unroll
                    for (int i = 0; i < 4; ++i) { const float a = fmaxf(v0[i], 0.f), b = fmaxf(v1[i], 0.f); v0[i] = a * a; v1[i] = b * b; }
                    wv[bj] = pack8(v0, v1); }
                lane_tr2(xs, fr, fq, wv[0], wv[1]); __builtin_nontemporal_store(wv[0], (u32x4*)rowp); __builtin_nontemporal_store(wv[1], (u32x4*)(rowp + 128)); }
    }
};
struct EpiS {
    float* S;
    __device__ __forceinline__ void operator()(const AccT& acc, const Unit& u, int wr, int wc, int fr, int fq) const {
        const int row0 = u.pm * 256 + wr * 64 + fr, col0 = wc * 32 + 8 * fq;
#pragma unroll
        for (int ai = 0; ai < 2; ++ai)
#pragma unroll
            for (int m = 0; m < 4; ++m) { const int r = row0 + ai * 128 + m * 16; float* p = S + ((size_t)u.pb * NCH + r) * 128 + col0;
                *(f32x4*)p = acc[ai][0][m][0]; *(f32x4*)(p + 4) = acc[ai][0][m][1]; }
    }
};
__device__ __forceinline__ float gelu_tanh(float x) { const float z = 0.7978845608028654f * (x + 0.044715f * x * x * x); return x * __builtin_amdgcn_rcpf(1.0f + __builtin_amdgcn_exp2f(-2.0f * LOG2E * z)); }
struct EpiY {
    const bf16_t* UX; const float* Dsk; bf16_t* Y; XS xs;
    __device__ __forceinline__ void operator()(const AccT& acc, const Unit& u, int wr, int wc, int fr, int fq) const {
        const int g = u.pb; const int r0 = u.pm * 256 + wr * 64 + fr; const int colb = wc * 32 + 8 * fq, c0 = colb & 15;
        const f32x4 d0 = *(const f32x4*)(Dsk + g * 16 + c0), d1 = *(const f32x4*)(Dsk + g * 16 + c0 + 4);
        const unsigned offU0 = (unsigned)(((size_t)g * NCH + r0) * UXLD + colb) * 2u;
        const int colb2 = wc * 32 + 8 * (xs.lane & 3);
        unsigned offY = (unsigned)(((size_t)(r0 - fr + (xs.lane >> 2)) * 16 + (colb2 >> 4)) * DM + g * 16 + (colb2 & 15)) * 2u;
        u32x4 ur[2][4][2];
#pragma unroll
        for (int ai = 0; ai < 2; ++ai)
#pragma unroll
            for (int m = 0; m < 4; ++m)
#pragma unroll
                for (int bj = 0; bj < 2; ++bj) ur[ai][m][bj] = *(const u32x4*)((const char*)UX + offU0 + (unsigned)((ai * 128 + m * 16) * UXLD * 2 + bj * 256));
        asm volatile("" ::: "memory");
#pragma unroll
        for (int ai = 0; ai < 2; ++ai)
#pragma unroll
            for (int m = 0; m < 4; ++m) {
                asm volatile("" : "+v"(offY)); u32x4 wv[2];
#pragma unroll
                for (int bj = 0; bj < 2; ++bj) {
                    const u32x4 uw = ur[ai][m][bj]; u32x4 ow;
                    { f32x4 v = acc[ai][bj][m][0] + d0 * (f32x4){bflo(uw.x), bfhi(uw.x), bflo(uw.y), bfhi(uw.y)};
#pragma unroll
                      for (int i = 0; i < 4; ++i) v[i] = gelu_tanh(v[i]);
                      ow.x = cvtpk(v[0], v[1]); ow.y = cvtpk(v[2], v[3]); }
                    { f32x4 v = acc[ai][bj][m][1] + d1 * (f32x4){bflo(uw.z), bfhi(uw.z), bflo(uw.w), bfhi(uw.w)};
#pragma unroll
                      for (int i = 0; i < 4; ++i) v[i] = gelu_tanh(v[i]);
                      ow.z = cvtpk(v[0], v[1]); ow.w = cvtpk(v[2], v[3]); }
                    wv[bj] = ow; }
                lane_tr2(xs, fr, fq, wv[0], wv[1]);
                *(u32x4*)((char*)Y + offY) = wv[0]; *(u32x4*)((char*)Y + offY + 8 * DM * 2) = wv[1];
                offY += (m == 3 ? 80 : 16) * 16 * DM * 2;
            }
    }
};
struct EpiGLU {
    const bf16_t* Hin; bf16_t* Hout; float* SS; XS xs;
    __device__ __forceinline__ void operator()(const AccT& acc, const Unit& u, int wr, int wc, int fr, int fq) const {
        const int row0 = u.pm * 256 + wr * 64 + fr, col0 = u.pn * 128 + wc * 32 + 8 * fq;
        u32x4 hr[2][4];
#pragma unroll
        for (int ai = 0; ai < 2; ++ai)
#pragma unroll
            for (int m = 0; m < 4; ++m) hr[ai][m] = *(const u32x4*)(Hin + (size_t)(row0 + ai * 128 + m * 16) * DM + col0);
        asm volatile("" ::: "memory");
#pragma unroll
        for (int ai = 0; ai < 2; ++ai)
#pragma unroll
            for (int m = 0; m < 4; ++m) { const int r = row0 + ai * 128 + m * 16; const size_t off = (size_t)r * DM + col0;
                f32x4 h0, h1; unpack8(hr[ai][m], h0, h1);
                f32x4 v0, v1;
#pragma unroll
                for (int i = 0; i < 4; ++i) {
                    v0[i] = h0[i] + acc[ai][0][m][0][i] * __builtin_amdgcn_rcpf(1.0f + __builtin_amdgcn_exp2f(-LOG2E * acc[ai][1][m][0][i]));
                    v1[i] = h1[i] + acc[ai][0][m][1][i] * __builtin_amdgcn_rcpf(1.0f + __builtin_amdgcn_exp2f(-LOG2E * acc[ai][1][m][1][i])); }
                float q = (v0[0] * v0[0] + v0[1] * v0[1]) + (v0[2] * v0[2] + v0[3] * v0[3]) + (v1[0] * v1[0] + v1[1] * v1[1]) + (v1[2] * v1[2] + v1[3] * v1[3]);
                { u32x4 w = pack8(v0, v1); lane_tr1(xs, fr, fq, w); *(u32x4*)(Hout + (size_t)(r - fr + (xs.lane >> 2)) * DM + u.pn * 128 + wc * 32 + 8 * (xs.lane & 3)) = w; }
                q += xshfl<16>(q); q = sum32(q); if (fq == 0) SS[(size_t)r * 32 + u.pn * 4 + wc] = q; (void)off; }
    }
};

struct Params {
    const float* x; const float* meta; const float* attn_nw; const float* wqkv; const float* sinks; const float* wo;
    const float* ssm_nw; const float* lre; const float* lim; const float* logdt; const float* bre; const float* bim; const float* cre; const float* cim; const float* dsk; const float* wglu;
    const float* mlp_nw; const float* wup; const float* wdn; const float* fnw;
    float* out; unsigned char* ws;
};


__device__ __forceinline__ void transpose_item(const float* W, int K, int N, bf16_t* WT, const float* kscale, bool glu, LAS float* scr, int item, int lane) {
    const int nblk = N / 32, kb = item / nblk, nb = item % nblk, k0 = 64 * kb, n0 = 32 * nb;
#pragma unroll 8
    for (int i = 0; i < 32; ++i) { const int kk = 2 * i + (lane >> 5); float v = W[(size_t)(k0 + kk) * N + n0 + (lane & 31)]; if (kscale) v *= kscale[k0 + kk]; scr[kk * 33 + (lane & 31)] = v; }
    asm volatile("s_waitcnt lgkmcnt(0)" ::: "memory");
    const int c = lane & 7;
#pragma unroll
    for (int j = 0; j < 4; ++j) { const int n = (lane >> 3) + 8 * j; const LAS float* s = scr + (8 * c) * 33 + n;
        u32x4 o; o.x = cvtpk(s[0 * 33], s[1 * 33]); o.y = cvtpk(s[2 * 33], s[3 * 33]); o.z = cvtpk(s[4 * 33], s[5 * 33]); o.w = cvtpk(s[6 * 33], s[7 * 33]);
        int nd = n0 + n; if (glu) { const int bj = nd >> 10, rem = nd & 1023; nd = (rem >> 7) * 256 + bj * 128 + (rem & 127); }
        *(u32x4*)(WT + (size_t)nd * K + k0 + 8 * c) = o; }
    asm volatile("s_waitcnt lgkmcnt(0)" ::: "memory");
}

struct SsmP { float lr, li, dt; };
__device__ __forceinline__ void cpow(const SsmP& s, float tau, float& re, float& im) { const float mag = expf(s.lr * s.dt * tau); float sn, cs; sincosf(s.li * s.dt * tau, &sn, &cs); re = mag * cs; im = mag * sn; }
__device__ __forceinline__ void ccoef(const SsmP& s, float& re, float& im) {
    float ar, ai; cpow(s, 1.0f, ar, ai); ar -= 1.0f; const float den = 1.0f / (s.lr * s.lr + s.li * s.li);
    re = (ar * s.lr + ai * s.li) * den; im = (ai * s.lr - ar * s.li) * den;
}

template <int MODE> __device__ __forceinline__ void meta_gemm(const bf16_t* A, int lda, const bf16_t* Wt, int N, int K, int gw, int NGW, int lane,
                                                              const float* rs0, bf16_t* o0, bf16_t* o1, bf16_t* o2, const bf16_t* hin) {
    float rsv = 1.0f;
    if (MODE == 2) {
        for (int r = 0; r < 16; ++r) { f32x4 v0, v1, v2, v3; const u32x4* hp = (const u32x4*)(A + (size_t)r * lda + lane * 16); unpack8(hp[0], v0, v1); unpack8(hp[1], v2, v3);
            float s = (v0[0] * v0[0] + v0[1] * v0[1]) + (v0[2] * v0[2] + v0[3] * v0[3]) + (v1[0] * v1[0] + v1[1] * v1[1]) + (v1[2] * v1[2] + v1[3] * v1[3])
                    + (v2[0] * v2[0] + v2[1] * v2[1]) + (v2[2] * v2[2] + v2[3] * v2[3]) + (v3[0] * v3[0] + v3[1] * v3[1]) + (v3[2] * v3[2] + v3[3] * v3[3]);
            s = wave_sum(s); if (lane == r) rsv = 1.0f / sqrtf(s * (1.0f / DM) + EPS); }
    }
    for (int n = gw; n < N; n += NGW) {
        float acc[16];
#pragma unroll
        for (int r = 0; r < 16; ++r) acc[r] = 0.f;
        for (int k0 = lane * 8; k0 < K; k0 += 512) {
            f32x4 w0, w1; unpack8(*(const u32x4*)(Wt + (size_t)n * K + k0), w0, w1);
#pragma unroll
            for (int r = 0; r < 16; ++r) { f32x4 a0, a1; unpack8(*(const u32x4*)(A + (size_t)r * lda + k0), a0, a1);
                acc[r] += (a0[0] * w0[0] + a0[1] * w0[1]) + (a0[2] * w0[2] + a0[3] * w0[3]) + (a1[0] * w1[0] + a1[1] * w1[1]) + (a1[2] * w1[2] + a1[3] * w1[3]); }
        }
        float v = 0.f;
#pragma unroll
        for (int r = 0; r < 16; ++r) { const float s = wave_sum(acc[r]); v = (lane == r) ? s : v; }
        if (lane < 16) { const size_t row = MREAL + lane;
            if (MODE == 0) { v *= rs0[row]; bf16_t* dst; if (n < 1024) { v *= 0.125f * LOG2E; dst = o0 + row * DM + n; } else if (n < 1280) dst = o1 + row * 256 + (n - 1024); else dst = o2 + row * 256 + (n - 1280);
                *dst = (bf16_t)(cvtpk(v, 0.f) & 0xffffu); }
            else if (MODE == 1 || MODE == 3) { v += bflo((unsigned)hin[row * DM + n]); o0[row * DM + n] = (bf16_t)(cvtpk(v, 0.f) & 0xffffu); }
            else { v = fmaxf(v * rsv, 0.f); v = v * v; o0[row * FF + n] = (bf16_t)(cvtpk(v, 0.f) & 0xffffu); }
        }
    }
}

constexpr int KS_LD = 72, VT_LD = 296, KS_BYTES = 288 * KS_LD * 2;
struct AttnUnit { int b, kvh, qb; bool meta; };
__device__ __forceinline__ AttnUnit attn_unit(int L) { AttnUnit u; u.meta = L >= 2048; u.b = 0; u.qb = 0; if (!u.meta) { u.b = L >> 7; u.kvh = (L >> 5) & 3; u.qb = L & 31; } else u.kvh = L - 2048; return u; }
__device__ __forceinline__ void attn_fetch(const AttnUnit& u, const bf16_t* Kb, const bf16_t* Vb, int i, u32x4& kv, u32x4& vv) {
    const int kk = i >> 3, ch = i & 7; long row = -1;
    if (kk < 256) { const int s = u.qb * 128 - 128 + kk; if (!u.meta && s >= 0) row = (long)u.b * SEQ + s; } else if (kk < 272) row = MREAL + (kk - 256);
    kv = (u32x4){0u, 0u, 0u, 0u}; vv = (u32x4){0u, 0u, 0u, 0u};
    if (row >= 0) { kv = *(const u32x4*)(Kb + row * 256 + u.kvh * 64 + ch * 8); vv = *(const u32x4*)(Vb + row * 256 + u.kvh * 64 + ch * 8); }
}
template <bool SLOW> __device__ __forceinline__ void attn_tile(const LAS bf16_t* Ks, const LAS bf16_t* Vt, bf16_t* qp, const bf16x8 (&qf)[4], int rt, int t0, bool meta, float slope, float sink, int q, int hi, int piq) {
    int qq = q - 8 * hi; asm volatile("" : "+v"(qq));
    const float cb0 = -slope * (float)(128 + qq);
    float tr[16];
#pragma unroll
    for (int r = 0; r < 16; ++r) tr[r] = slope * (float)((r & 7) + 16 * (r >> 3));
    f32x16 S[6];
#pragma unroll
    for (int k6 = 0; k6 < 6; ++k6) { const int kt = (k6 < 5) ? rt + k6 : 8; const float c0 = (k6 < 5) ? cb0 + slope * (float)(32 * k6) : 0.f;
        f32x16 a;
#pragma unroll
        for (int r = 0; r < 16; ++r) a[r] = (k6 < 5) ? c0 + tr[r] : 0.f;
        const LAS bf16_t* kp = Ks + (32 * kt + piq) * KS_LD + hi * 8;
#pragma unroll
        for (int dk = 0; dk < 4; ++dk) a = __builtin_amdgcn_mfma_f32_32x32x16_bf16(*(const LAS bf16x8*)(kp + dk * 16), qf[dk], a, 0, 0, 0);
        S[k6] = a; asm volatile("" ::: "memory"); }
    float mx = sink;
    if (!SLOW) {
#pragma unroll
        for (int k6 = 0; k6 < 5; ++k6)
#pragma unroll
            for (int r = 0; r < 16; ++r) { const int kc = (r & 7) + 16 * (r >> 3); float v = S[k6][r];
                if (k6 == 0) v = (kc > qq) ? v : -1e30f;
                if (k6 == 4) v = (kc <= qq) ? v : -1e30f;
                S[k6][r] = v; mx = fmaxf(mx, v); }
#pragma unroll
        for (int r = 0; r < 8; ++r) mx = fmaxf(mx, S[5][r]);
    } else {
        const unsigned lim1 = meta ? 0u : (unsigned)min(128, t0 + 32 * rt + q + 1);
        const int qlim = meta ? q : 15;
#pragma unroll
        for (int k6 = 0; k6 < 6; ++k6)
#pragma unroll
            for (int r = 0; r < ((k6 < 5) ? 16 : 8); ++r) { const int kc = (r & 7) + 16 * (r >> 3); bool ok; float v;
                if (k6 < 5) { const int dist = 128 + qq - 32 * k6 - kc; ok = (unsigned)dist < lim1; v = S[k6][r]; }
                else { ok = (kc + 8 * hi) <= qlim; v = S[k6][r]; }
                v = ok ? v : -1e30f; S[k6][r] = v; mx = fmaxf(mx, v); }
    }
    mx = max32(mx);
    float l = 0.f;
#pragma unroll
    for (int k6 = 0; k6 < 6; ++k6)
#pragma unroll
        for (int r = 0; r < ((k6 < 5) ? 16 : 8); ++r) { const float p = __builtin_amdgcn_exp2f(S[k6][r] - mx); S[k6][r] = p; l += p; }
    l = sum32(l); l += __builtin_amdgcn_exp2f(sink - mx);
    f32x16 O[2]; O[0] = f32x16{}; O[1] = f32x16{};
#pragma unroll
    for (int k6 = 0; k6 < 6; ++k6) { const int kt = (k6 < 5) ? rt + k6 : 8;
#pragma unroll
        for (int hf = 0; hf < ((k6 < 5) ? 2 : 1); ++hf) {
            u32x4 pw; pw.x = cvtpk(S[k6][8 * hf + 0], S[k6][8 * hf + 1]); pw.y = cvtpk(S[k6][8 * hf + 2], S[k6][8 * hf + 3]); pw.z = cvtpk(S[k6][8 * hf + 4], S[k6][8 * hf + 5]); pw.w = cvtpk(S[k6][8 * hf + 6], S[k6][8 * hf + 7]);
            const bf16x8 pb = __builtin_bit_cast(bf16x8, pw);
#pragma unroll
            for (int dt = 0; dt < 2; ++dt) { const bf16x8 va = *(const LAS bf16x8*)(Vt + (32 * dt + q) * VT_LD + 32 * kt + 16 * hf + 8 * hi);
                O[dt] = __builtin_amdgcn_mfma_f32_32x32x16_bf16(va, pb, O[dt], 0, 0, 0); }
            asm volatile("" ::: "memory"); } }
    const float rl = 1.0f / l;
#pragma unroll
    for (int dt = 0; dt < 2; ++dt)
#pragma unroll
        for (int j = 0; j < 4; ++j) { u32x2 w; w.x = cvtpk(O[dt][4 * j] * rl, O[dt][4 * j + 1] * rl); w.y = cvtpk(O[dt][4 * j + 2] * rl, O[dt][4 * j + 3] * rl);
            if (!meta || q < 16) *(u32x2*)(qp + 32 * dt + 8 * j + 4 * hi) = w; }
}
__device__ __forceinline__ void attn_phase(LAS unsigned char* lds, bf16_t* Q, const bf16_t* Kb, const bf16_t* Vb, const float* sinks, int vcu, int G, int wave_) {
    const int tid_ = fresh_tid(wave_);
    const int tid = tid_, lane = tid & 63, wid = wave_, q = lane & 31, hi = lane >> 5;
    LAS bf16_t* Ks = (LAS bf16_t*)lds; LAS bf16_t* Vt = (LAS bf16_t*)(lds + KS_BYTES);
    const int piq = (q & 0x13) | ((q & 4) << 1) | ((q & 8) >> 1);
#pragma unroll 1
    for (int L = vcu; L < 2052; L += G) {
        const AttnUnit u = attn_unit(L);
        const bool meta = u.meta; const int b = u.b, kvh = u.kvh, qb = u.qb, t0 = qb * 128;
        __syncthreads();
        {
            int tl = tid; asm volatile("" : "+v"(tl));
            u32x4 pk[5], pv[5];
#pragma unroll
            for (int it = 0; it < 5; ++it) { const int i = tl + 512 * it; if (i < 288 * 8) attn_fetch(u, Kb, Vb, i, pk[it], pv[it]); }
#pragma unroll
            for (int it = 0; it < 5; ++it) { const int i = tl + 512 * it;
                if (i < 288 * 8) { const int kk = i >> 3, ch = i & 7; const u32x4 kv = pk[it], vv = pv[it];
                    *(LAS u32x4*)(Ks + kk * KS_LD + ch * 8) = kv;
                    LAS bf16_t* vp = Vt + (ch * 8) * VT_LD + kk;
                    vp[0 * VT_LD] = (bf16_t)(vv.x & 0xffffu); vp[1 * VT_LD] = (bf16_t)(vv.x >> 16); vp[2 * VT_LD] = (bf16_t)(vv.y & 0xffffu); vp[3 * VT_LD] = (bf16_t)(vv.y >> 16);
                    vp[4 * VT_LD] = (bf16_t)(vv.z & 0xffffu); vp[5 * VT_LD] = (bf16_t)(vv.z >> 16); vp[6 * VT_LD] = (bf16_t)(vv.w & 0xffffu); vp[7 * VT_LD] = (bf16_t)(vv.w >> 16); } }
        }
        const int hq = kvh * 4 + (wid >> 1);
        bf16x8 qf[4], qn[4];
        const int rt0 = (wid & 1) * 2; const long qrow0 = meta ? (long)(MREAL + q) : (long)b * SEQ + t0 + 32 * rt0 + q;
        bf16_t* qp0 = Q + qrow0 * DM + hq * 64; bf16_t* qp1 = qp0 + (meta ? 0 : 32 * DM);
#pragma unroll
        for (int dk = 0; dk < 4; ++dk) { qf[dk] = *(const bf16x8*)(qp0 + dk * 16 + hi * 8); qn[dk] = *(const bf16x8*)(qp1 + dk * 16 + hi * 8); }
        __syncthreads();
        const float slope = exp2f(-0.5f * (float)(hq + 1)) * LOG2E, sink = sinks[hq] * LOG2E;
        if (meta || qb == 0) {
            if (!meta || rt0 == 0) attn_tile<true>(Ks, Vt, qp0, qf, rt0, t0, meta, slope, sink, q, hi, piq);
            if (!meta) { asm volatile("" ::: "memory"); attn_tile<true>(Ks, Vt, qp1, qn, rt0 + 1, t0, meta, slope, sink, q, hi, piq); }
        } else {
            attn_tile<false>(Ks, Vt, qp0, qf, rt0, t0, false, slope, sink, q, hi, piq);
            asm volatile("" ::: "memory");
            attn_tile<false>(Ks, Vt, qp1, qn, rt0 + 1, t0, false, slope, sink, q, hi, piq);
        }
    }
    __syncthreads();
}

#define XB_TMO      128
#define XB_XCNT(j)  (256  + 64 * (j))
#define XB_XSUB(j)  (1280 + 64 * (j))
#define XB_XGEN(j)  (2304 + 64 * (j))
#define XB_TOP      3328
#define XB_TOPGEN   3392
#define XCD_BAR_WORDS 3456
#define XB_SPIN_CAP (1u << 18)
__device__ __forceinline__ unsigned xb_ld(unsigned* p)              { return __hip_atomic_load(p, __ATOMIC_RELAXED, __HIP_MEMORY_SCOPE_AGENT); }
__device__ __forceinline__ unsigned xb_add(unsigned* p, unsigned v) { return __hip_atomic_fetch_add(p, v, __ATOMIC_RELAXED, __HIP_MEMORY_SCOPE_AGENT); }
__device__ __forceinline__ unsigned xb_xcc_id() { return (unsigned)__builtin_amdgcn_s_getreg((3 << 11) | 20) & 0xFu; }
#define XB_SPIN(cond, bar) do { unsigned _sp = 0; while (cond) { __builtin_amdgcn_s_sleep(1); \
    if ((++_sp & 255u) == 0u) { if (xb_ld(&(bar)[XB_TMO])) break; if (_sp > XB_SPIN_CAP) { atomicAdd(&(bar)[XB_TMO], 1u); break; } } } } while (0)
struct XcdBarrier { unsigned* bar; unsigned x; volatile LAS unsigned* st; };
__device__ __forceinline__ XcdBarrier xcd_barrier_post(unsigned* bar, volatile LAS unsigned* st) {
    XcdBarrier b; b.bar = bar; b.x = xb_xcc_id(); b.st = st;
    if (threadIdx.x == 0) (void)xb_add(&bar[XB_XCNT(b.x)], 1u);
    return b;
}
__device__ __forceinline__ void xcd_barrier_complete(unsigned* bar, unsigned x, unsigned& nloc, unsigned& nx) {
    const unsigned G = gridDim.x * gridDim.y * gridDim.z;
    unsigned sum, cnt, mine, sp = 0u;
    for (;;) {
        sum = 0u; cnt = 0u; mine = 0u;
#pragma unroll
        for (unsigned j = 0; j < 16; ++j) { const unsigned c = xb_ld(&bar[XB_XCNT(j)]); sum += c; cnt += (c > 0u) ? 1u : 0u; mine = (j == x) ? c : mine; }
        if (sum == G) break;
        __builtin_amdgcn_s_sleep(1);
        if ((++sp & 255u) == 0u) { if (xb_ld(&bar[XB_TMO])) break; if (sp > XB_SPIN_CAP) { atomicAdd(&bar[XB_TMO], 1u); break; } }
    }
    nloc = mine > 0u ? mine : 1u; nx = cnt > 0u ? cnt : 1u;
}
__device__ __forceinline__ void xcd_barrier(const XcdBarrier& b) {
    asm volatile("s_waitcnt vmcnt(0)" ::: "memory");
    __syncthreads();
    if (threadIdx.x == 0) {
        unsigned* bar = b.bar;
        __builtin_amdgcn_s_waitcnt(0);
        unsigned nloc = b.st[0], nx = b.st[1];
        if (nloc == 0u) { xcd_barrier_complete(bar, b.x, nloc, nx); b.st[0] = nloc; b.st[1] = nx; }
        const unsigned old = xb_add(&bar[XB_XSUB(b.x)], 1u);
        const unsigned gen = old / nloc;
        if (old + 1u == (gen + 1u) * nloc) {
            __builtin_amdgcn_fence(__ATOMIC_RELEASE, "agent");
            asm volatile("s_waitcnt vmcnt(0)" ::: "memory");
            const unsigned og = xb_add(&bar[XB_TOP], 1u);
            const unsigned tg = og / nx;
            if (og + 1u == (tg + 1u) * nx) xb_add(&bar[XB_TOPGEN], 1u);
            else XB_SPIN(xb_ld(&bar[XB_TOPGEN]) == tg, bar);
            __builtin_amdgcn_fence(__ATOMIC_ACQUIRE, "agent");
            xb_add(&bar[XB_XGEN(b.x)], 1u);
            asm volatile("s_waitcnt vmcnt(0)" ::: "memory");
        } else {
            XB_SPIN(xb_ld(&bar[XB_XGEN(b.x)]) == gen, bar);
            __builtin_amdgcn_fence(__ATOMIC_ACQUIRE, "agent");
            asm volatile("s_waitcnt vmcnt(0)" ::: "memory");
        }
    }
    __syncthreads();
}

constexpr int LDS_BYTES = 151552;
#ifndef PHMASK
#define PHMASK 0xFFFF
#endif
#ifndef STAG_UP
#define STAG_UP 0
#endif
#define REP(k) for (int rep_ = 0; rep_ < ((DUPMASK >> (k)) & 1) + 1; ++rep_)
__global__ void __launch_bounds__(512, 2) fwd_kernel(Params P) {
    extern __shared__ __attribute__((aligned(16))) unsigned char lds_raw[];
    LAS unsigned char* lds = (LAS unsigned char*)lds_raw;
    cg::grid_group grid = cg::this_grid();
    const int wave = __builtin_amdgcn_readfirstlane((int)threadIdx.x >> 6);
    const int G = gridDim.x, bx = blockIdx.x;
    const int vcu = (G % 8 == 0) ? (bx % 8) * (G / 8) + bx / 8 : bx;
    const int gw = vcu * 8 + wave, NGW = G * 8;
    unsigned char* ws = P.ws;
#define mkxs() (XS{(LAS u32x4*)(lds + 132096 + wave * 2048), fresh_tid(wave) & 63})
    volatile LAS unsigned* bst = (volatile LAS unsigned*)(lds + 131072);
    if (threadIdx.x < 2) bst[threadIdx.x] = 0u;
    __syncthreads();
    const XcdBarrier xbar = xcd_barrier_post((unsigned*)(ws + WS_CTL), bst);
    bf16_t* Wqkv_t = (bf16_t*)(ws + WS_WQKV); bf16_t* Wo_t = (bf16_t*)(ws + WS_WO); bf16_t* Wup0_t = (bf16_t*)(ws + WS_WUP0); bf16_t* Wdn0_t = (bf16_t*)(ws + WS_WDN0);
    bf16_t* Wglu_t = (bf16_t*)(ws + WS_WGLU); bf16_t* Wup1_t = (bf16_t*)(ws + WS_WUP1); bf16_t* Wdn1_t = (bf16_t*)(ws + WS_WDN1);
    bf16_t* BW1 = (bf16_t*)(ws + WS_BW1); bf16_t* BW2 = (bf16_t*)(ws + WS_BW2); float* A16 = (float*)(ws + WS_A16); bf16_t* UM = (bf16_t*)(ws + WS_UM);
    float* RS0 = (float*)(ws + WS_RS0); float* SS1 = (float*)(ws + WS_SS1); float* SS3 = (float*)(ws + WS_SS3); float* SS4 = (float*)(ws + WS_SS4);
    bf16_t* HA = (bf16_t*)(ws + WS_RA); bf16_t* HB = (bf16_t*)(ws + WS_RB);
    bf16_t* Qb = (bf16_t*)(ws + WS_Q); bf16_t* Kb = (bf16_t*)(ws + WS_K); bf16_t* Vb = (bf16_t*)(ws + WS_V); bf16_t* ACT = (bf16_t*)(ws + WS_ACT);
    bf16_t* UX = (bf16_t*)(ws + WS_UX); float* Sst = (float*)(ws + WS_S); bf16_t* Yb = (bf16_t*)(ws + WS_Y);

    REP(0) if (PHMASK & 1) {
        const int t_ = fresh_tid(wave); const int tid = t_, lane = tid & 63; (void)tid; (void)lane;
        LAS float* scr = (LAS float*)(lds + wave * 16384);
        constexpr int I_QKV = 16 * 48, I_O = 16 * 32, I_UP = 16 * 128, I_DN = 64 * 32, I_GLU = 16 * 64;
        constexpr int NITEMS = I_QKV + I_O + 2 * I_UP + 2 * I_DN + I_GLU;
        for (int it = gw; it < NITEMS; it += NGW) {
            int r = it;
            if (r < I_QKV) { transpose_item(P.wqkv, DM, NQKV, Wqkv_t, P.attn_nw, false, scr, r, lane); continue; } r -= I_QKV;
            if (r < I_O) { transpose_item(P.wo, DM, DM, Wo_t, nullptr, false, scr, r, lane); continue; } r -= I_O;
            if (r < I_UP) { transpose_item(P.wup, DM, FF, Wup0_t, P.mlp_nw, false, scr, r, lane); continue; } r -= I_UP;
            if (r < I_DN) { transpose_item(P.wdn, FF, DM, Wdn0_t, nullptr, false, scr, r, lane); continue; } r -= I_DN;
            if (r < I_GLU) { transpose_item(P.wglu, DM, 2 * DM, Wglu_t, nullptr, true, scr, r, lane); continue; } r -= I_GLU;
            if (r < I_UP) { transpose_item(P.wup + (size_t)DM * FF, DM, FF, Wup1_t, P.mlp_nw + DM, false, scr, r, lane); continue; } r -= I_UP;
            transpose_item(P.wdn + (size_t)FF * DM, FF, DM, Wdn1_t, nullptr, false, scr, r, lane);
        }
        for (int m = gw; m < MREAL + NMETA; m += NGW) {
            unsigned long long* o8 = (unsigned long long*)(HA + (size_t)m * DM) + lane;
            const float* src = (m < MREAL) ? P.x + (size_t)m * DM : P.meta + (size_t)(m - MREAL) * DM;
            const f32x4* xr = (const f32x4*)src + lane; f32x4 v[4]; float s = 0.f;
#pragma unroll
            for (int j = 0; j < 4; ++j) { v[j] = xr[64 * j]; s += (v[j].x * v[j].x + v[j].y * v[j].y) + (v[j].z * v[j].z + v[j].w * v[j].w); }
            s = wave_sum(s);
#pragma unroll
            for (int j = 0; j < 4; ++j) o8[64 * j] = (unsigned long long)cvtpk(v[j].x, v[j].y) | ((unsigned long long)cvtpk(v[j].z, v[j].w) << 32);
            if (lane == 0) RS0[m] = 1.0f / sqrtf(s * (1.0f / DM) + EPS);
        }
        __syncthreads();
        {
            LAS float* AP = (LAS float*)lds;
            LAS float* BB = AP + 17 * 64 * 2;
            LAS float* CC = BB + 64 * 16 * 2;
            LAS float* KT = CC + 16 * 64 * 2;
            for (int item = vcu; item < 256; item += G) {
                const int g = item >> 2, qd = item & 3;
                const float dt = expf(P.logdt[g]);
                for (int idx = tid; idx < 17 * 64; idx += 512) { const int tau = idx >> 6, p = idx & 63;
                    SsmP s; s.lr = fminf(P.lre[g * 64 + p], -1e-4f); s.li = P.lim[g * 64 + p]; s.dt = dt; float ar, ai; cpow(s, (float)tau, ar, ai); AP[idx * 2] = ar; AP[idx * 2 + 1] = ai; }
                for (int idx = tid; idx < 64 * 16; idx += 512) { const int p = idx >> 4;
                    SsmP s; s.lr = fminf(P.lre[g * 64 + p], -1e-4f); s.li = P.lim[g * 64 + p]; s.dt = dt; float cr, ci; ccoef(s, cr, ci);
                    const float br = P.bre[g * 1024 + idx], bi = P.bim[g * 1024 + idx]; BB[idx * 2] = cr * br - ci * bi; BB[idx * 2 + 1] = cr * bi + ci * br; }
                for (int idx = tid; idx < 16 * 64; idx += 512) { CC[idx * 2] = P.cre[g * 1024 + idx]; CC[idx * 2 + 1] = P.cim[g * 1024 + idx]; }
                __syncthreads();
                for (int idx = tid; idx < 4096; idx += 512) { const int tau = idx >> 8, c = (idx >> 4) & 15, cp = idx & 15; float k = 0.f;
                    for (int p = 0; p < 64; ++p) { const float ar = AP[(tau * 64 + p) * 2], ai = AP[(tau * 64 + p) * 2 + 1], br = BB[(p * 16 + cp) * 2], bi = BB[(p * 16 + cp) * 2 + 1];
                        k += CC[(c * 64 + p) * 2] * (ar * br - ai * bi) - CC[(c * 64 + p) * 2 + 1] * (ar * bi + ai * br); }
                    KT[idx] = k; }
                __syncthreads();
                for (int idx = tid; idx < 64 * 32; idx += 512) { const int n = qd * 64 + (idx >> 5), k0 = (idx & 31) * 8, ti = n >> 4, c = n & 15, si = k0 >> 4, cp0 = k0 & 15;
                    u32x4 w = (u32x4){0u, 0u, 0u, 0u};
                    if (si <= ti) { const LAS float* kp = KT + ((ti - si) * 16 + c) * 16 + cp0; w.x = cvtpk(kp[0], kp[1]); w.y = cvtpk(kp[2], kp[3]); w.z = cvtpk(kp[4], kp[5]); w.w = cvtpk(kp[6], kp[7]); }
                    *(u32x4*)(BW2 + ((size_t)g * 256 + n) * UXLD + k0) = w; }
                for (int idx = tid; idx < 64 * 16; idx += 512) { const int n = qd * 64 + (idx >> 4), p0 = (idx & 15) * 4, ti = n >> 4, c = n & 15; unsigned w[4];
#pragma unroll
                    for (int j = 0; j < 4; ++j) { const int p = p0 + j; const float cr = CC[(c * 64 + p) * 2], ci = CC[(c * 64 + p) * 2 + 1], ar = AP[((ti + 1) * 64 + p) * 2], ai = AP[((ti + 1) * 64 + p) * 2 + 1];
                        w[j] = cvtpk(cr * ar - ci * ai, -(cr * ai + ci * ar)); }
                    *(u32x4*)(BW2 + ((size_t)g * 256 + n) * UXLD + 256 + 2 * p0) = (u32x4){w[0], w[1], w[2], w[3]}; }
                for (int idx = tid; idx < 16 * 32; idx += 512) { const int p = qd * 16 + (idx >> 5), k0 = (idx & 31) * 8, si = k0 >> 4, cp0 = k0 & 15;
                    const float ar = AP[((15 - si) * 64 + p) * 2], ai = AP[((15 - si) * 64 + p) * 2 + 1]; float re[8], im[8];
#pragma unroll
                    for (int j = 0; j < 8; ++j) { const float br = BB[(p * 16 + cp0 + j) * 2], bi = BB[(p * 16 + cp0 + j) * 2 + 1]; re[j] = ar * br - ai * bi; im[j] = ar * bi + ai * br; }
                    *(u32x4*)(BW1 + ((size_t)g * 256 + 2 * p) * 256 + k0) = (u32x4){cvtpk(re[0], re[1]), cvtpk(re[2], re[3]), cvtpk(re[4], re[5]), cvtpk(re[6], re[7])};
                    *(u32x4*)(BW1 + ((size_t)g * 256 + 2 * p + 1) * 256 + k0) = (u32x4){cvtpk(im[0], im[1]), cvtpk(im[2], im[3]), cvtpk(im[4], im[5]), cvtpk(im[6], im[7])}; }
                for (int idx = tid; idx < 32 * 32; idx += 512) { const int n = 128 + qd * 32 + (idx >> 5), k0 = (idx & 31) * 8;
                    *(u32x4*)(BW1 + ((size_t)g * 256 + n) * 256 + k0) = (u32x4){0u, 0u, 0u, 0u}; }
                if (qd == 0 && tid < 64) { A16[2 * (g * 64 + tid)] = AP[(16 * 64 + tid) * 2]; A16[2 * (g * 64 + tid) + 1] = AP[(16 * 64 + tid) * 2 + 1]; }
                __syncthreads();
            }
        }
    }
    if (gridDim.y == 0x7fffffffu) grid.sync();
    xcd_barrier(xbar);

    REP(1) if (PHMASK & (1 << 1)) {
        pg8::Gemm g{HA, Wqkv_t, DM, DM, DM, 0, 0}; pg8::StaticOrder S; S.init(MREAL, NQKV, G, bx);
        EpiQKV E{Qb, Kb, Vb, RS0, 0.125f * LOG2E, mkxs()};
        pg8::gemm_phase(lds, g, S, E, wave);
        { const int t_ = fresh_tid(wave); meta_gemm<0>(HA + (size_t)MREAL * DM, DM, Wqkv_t, NQKV, DM, gw, NGW, t_ & 63, RS0, Qb, Kb, Vb, nullptr); }
    }
    xcd_barrier(xbar);
    if (PHMASK & 4) attn_phase(lds, Qb, Kb, Vb, P.sinks, vcu, G, wave);
    xcd_barrier(xbar);
    REP(3) if (PHMASK & (1 << 3)) {
        pg8::Gemm g{Qb, Wo_t, DM, DM, DM, 0, 0}; pg8::StaticOrder S; S.init(MREAL, DM, G, bx);
        EpiResid E{HA, HB, SS1, mkxs()};
        pg8::gemm_phase(lds, g, S, E, wave);
        { const int t_ = fresh_tid(wave); meta_gemm<1>(Qb + (size_t)MREAL * DM, DM, Wo_t, DM, DM, gw, NGW, t_ & 63, nullptr, HB, nullptr, nullptr, HA); }
    }
    xcd_barrier(xbar);
    REP(4) if (PHMASK & (1 << 4)) {
        pg8::Gemm g{HB, Wup0_t, DM, DM, DM, 0, 0}; pg8::StaticOrder S; S.init(MREAL, FF, G, bx);
        EpiUp<16> E{SS1, ACT, mkxs()};
        pg8::gemm_phase(lds, g, S, E, wave, STAG_UP);
        { const int t_ = fresh_tid(wave); meta_gemm<2>(HB + (size_t)MREAL * DM, DM, Wup0_t, FF, DM, gw, NGW, t_ & 63, nullptr, ACT, nullptr, nullptr, nullptr); }
    }
    xcd_barrier(xbar);
    REP(5) if (PHMASK & (1 << 5)) {
        pg8::Gemm g{ACT, Wdn0_t, FF, FF, FF, 0, 0}; pg8::StaticOrder S; S.init(MREAL, DM, G, bx);
        EpiResid E{HB, HA, nullptr, mkxs()};
        pg8::gemm_phase(lds, g, S, E, wave);
        { const int t_ = fresh_tid(wave); meta_gemm<3>(ACT + (size_t)MREAL * FF, FF, Wdn0_t, DM, FF, gw, NGW, t_ & 63, nullptr, HA, nullptr, nullptr, HB); }
    }
    xcd_barrier(xbar);
    REP(6) if (PHMASK & (1 << 6)) {
        const int t_ = fresh_tid(wave); const int tid = t_, lane = tid & 63; (void)tid; (void)lane;
        f32x4 wv[4];
#pragma unroll
        for (int j = 0; j < 4; ++j) wv[j] = *(const f32x4*)(P.ssm_nw + lane * 16 + 4 * j);
        for (int ch = gw; ch < NCH + 1; ch += NGW) {
            const bool mt = ch == NCH;
            for (int ti = 0; ti < 16; ++ti) {
                const size_t row = mt ? (size_t)(MREAL + ti) : (size_t)ch * 16 + ti;
                const u32x4* hp = (const u32x4*)(HA + row * DM + lane * 16);
                f32x4 v[4]; unpack8(hp[0], v[0], v[1]); unpack8(hp[1], v[2], v[3]);
                float s = 0.f;
#pragma unroll
                for (int j = 0; j < 4; ++j) s += (v[j].x * v[j].x + v[j].y * v[j].y) + (v[j].z * v[j].z + v[j].w * v[j].w);
                s = wave_sum(s); const float rs = 1.0f / sqrtf(s * (1.0f / DM) + EPS);
#pragma unroll
                for (int j = 0; j < 4; ++j) v[j] = v[j] * rs * wv[j];
                bf16_t* dst = mt ? UM + lane * 256 + ti * 16 : UX + ((size_t)lane * NCH + ch) * UXLD + ti * 16;
                *(u32x4*)dst = pack8(v[0], v[1]); *(u32x4*)(dst + 8) = pack8(v[2], v[3]);
            }
        }
    }
    xcd_barrier(xbar);
    REP(7) if (PHMASK & (1 << 7)) {
        pg8::Gemm g{UX, BW1, 256, UXLD, 256, (size_t)NCH * UXLD, (size_t)256 * 256}; pg8::BatchOrder S{G, bx};
        EpiS E{Sst};
        pg8::gemm_phase(lds, g, S, E, wave);
    }
    xcd_barrier(xbar);
    REP(8) if (PHMASK & 256) {
        const int t_ = fresh_tid(wave); const int tid = t_, lane = tid & 63; (void)tid; (void)lane;
      if (tid < 256) {
        const int item = bx * 256 + tid;
        if (item < NB * 64 * 64) {
            const int p = item & 63, g = (item >> 6) & 63, b = item >> 12;
            const float ar = A16[2 * (g * 64 + p)], ai = A16[2 * (g * 64 + p) + 1];
            float xr = 0.f, xi = 0.f;
            { const bf16_t* um = UM + g * 256; const bf16_t* w0 = BW1 + ((size_t)g * 256 + 2 * p) * 256; const bf16_t* w1 = w0 + 256;
                for (int k = 0; k < 256; k += 8) { f32x4 u0, u1, a0, a1, b0, b1; unpack8(*(const u32x4*)(um + k), u0, u1); unpack8(*(const u32x4*)(w0 + k), a0, a1); unpack8(*(const u32x4*)(w1 + k), b0, b1);
#pragma unroll
                    for (int i = 0; i < 4; ++i) { xr += u0[i] * a0[i] + u1[i] * a1[i]; xi += u0[i] * b0[i] + u1[i] * b1[i]; } } }
            const float* sp = Sst + ((size_t)g * NCH + b * 256) * 128 + 2 * p;
            bf16_t* xp = UX + ((size_t)g * NCH + b * 256) * UXLD + 256 + 2 * p;
            for (int j0 = 0; j0 < 256; j0 += 16) {
                f32x2_t sv[16];
#pragma unroll
                for (int j = 0; j < 16; ++j) sv[j] = *(const f32x2_t*)(sp + (size_t)(j0 + j) * 128);
#pragma unroll
                for (int j = 0; j < 16; ++j) { *(unsigned*)(xp + (size_t)(j0 + j) * UXLD) = cvtpk(xr, xi);
                    const float nr = ar * xr - ai * xi + sv[j].x, ni = ar * xi + ai * xr + sv[j].y; xr = nr; xi = ni; }
            }
        }
      }
    }
    xcd_barrier(xbar);
    REP(9) if (PHMASK & (1 << 9)) {
        pg8::Gemm g{UX, BW2, UXLD, UXLD, UXLD, (size_t)NCH * UXLD, (size_t)256 * UXLD}; pg8::BatchOrder S{G, bx};
        EpiY E{UX, P.dsk, Yb, mkxs()};
        pg8::gemm_phase(lds, g, S, E, wave);
    }
    xcd_barrier(xbar);
    REP(10) if (PHMASK & (1 << 10)) {
        pg8::Gemm g{Yb, Wglu_t, DM, DM, DM, 0, 0}; pg8::StaticOrder S; S.init(MREAL, 2 * DM, G, bx);
        EpiGLU E{HA, HB, SS3, mkxs()};
        pg8::gemm_phase(lds, g, S, E, wave);
    }
    xcd_barrier(xbar);
    REP(11) if (PHMASK & (1 << 11)) {
        pg8::Gemm g{HB, Wup1_t, DM, DM, DM, 0, 0}; pg8::StaticOrder S; S.init(MREAL, FF, G, bx);
        EpiUp<32> E{SS3, ACT, mkxs()};
        pg8::gemm_phase(lds, g, S, E, wave, STAG_UP);
    }
    xcd_barrier(xbar);
    REP(12) if (PHMASK & (1 << 12)) {
        pg8::Gemm g{ACT, Wdn1_t, FF, FF, FF, 0, 0}; pg8::StaticOrder S; S.init(MREAL, DM, G, bx);
        EpiResid E{HB, HA, SS4, mkxs()};
        pg8::gemm_phase(lds, g, S, E, wave);
    }
    xcd_barrier(xbar);
    for (int xs_ = 0; xs_ < XSYNC; ++xs_) xcd_barrier(xbar);
    REP(13) if (PHMASK & (1 << 13)) {
        const int t_ = fresh_tid(wave); const int tid = t_, lane = tid & 63; (void)tid; (void)lane;
      for (int m = gw; m < MREAL; m += NGW) {
        const float sl = (lane < 16) ? SS4[(size_t)m * 16 + lane] : 0.f;
        const float rs = 1.0f / sqrtf(wave_sum(sl) * (1.0f / DM) + EPS);
        const u32x4* hp = (const u32x4*)(HA + (size_t)m * DM);
        f32x4* op = (f32x4*)(P.out + (size_t)m * DM);
#pragma unroll
        for (int j = 0; j < 2; ++j) { f32x4 v0, v1; unpack8(hp[64 * j + lane], v0, v1);
            const f32x4 w0 = *(const f32x4*)(P.fnw + (64 * j + lane) * 8), w1 = *(const f32x4*)(P.fnw + (64 * j + lane) * 8 + 4);
            op[(64 * j + lane) * 2] = v0 * rs * w0; op[(64 * j + lane) * 2 + 1] = v1 * rs * w1; }
      }
    }
}

extern "C" void kernel_launch(void* const* d_in, const int* in_sizes, int n_in, void* d_out, int out_size, void* d_ws, size_t ws_size, hipStream_t stream) {
    static int grid = 0;
    if (grid == 0) {
        if (n_in != 20 || ws_size < WS_END) { fprintf(stderr, "kernel_launch: unexpected n_in %d or ws_size %zu (need %zu)\n", n_in, ws_size, (size_t)WS_END); grid = -1; return; }
        int dev = 0, cus = 0, per_cu = 0;
        hipGetDevice(&dev); hipDeviceGetAttribute(&cus, hipDeviceAttributeMultiprocessorCount, dev);
        hipFuncSetAttribute((const void*)fwd_kernel, hipFuncAttributeMaxDynamicSharedMemorySize, LDS_BYTES);
        hipOccupancyMaxActiveBlocksPerMultiprocessor(&per_cu, (const void*)fwd_kernel, 512, LDS_BYTES);
        if (per_cu < 1) { fprintf(stderr, "kernel_launch: occupancy query says %d blocks/CU\n", per_cu); per_cu = 1; }
        (void)hipGetLastError();
        grid = cus;
    }
    if (grid < 0) return;
    Params p{};
    p.x = (const float*)d_in[0]; p.meta = (const float*)d_in[1]; p.attn_nw = (const float*)d_in[2]; p.wqkv = (const float*)d_in[3]; p.sinks = (const float*)d_in[4]; p.wo = (const float*)d_in[5];
    p.ssm_nw = (const float*)d_in[6]; p.lre = (const float*)d_in[7]; p.lim = (const float*)d_in[8]; p.logdt = (const float*)d_in[9]; p.bre = (const float*)d_in[10]; p.bim = (const float*)d_in[11];
    p.cre = (const float*)d_in[12]; p.cim = (const float*)d_in[13]; p.dsk = (const float*)d_in[14]; p.wglu = (const float*)d_in[15]; p.mlp_nw = (const float*)d_in[16]; p.wup = (const float*)d_in[17];
    p.wdn = (const float*)d_in[18]; p.fnw = (const float*)d_in[19]; p.out = (float*)d_out; p.ws = (unsigned char*)d_ws;
    if (hipMemsetAsync((char*)d_ws + WS_CTL, 0, XCD_BAR_WORDS * 4, stream) != hipSuccess) { fprintf(stderr, "kernel_launch: memset failed\n"); return; }
    void* args[] = {&p};
    hipError_t e = hipLaunchCooperativeKernel((const void*)fwd_kernel, dim3(grid), dim3(512), args, LDS_BYTES, stream);
    if (e != hipSuccess) fprintf(stderr, "cooperative launch failed: %s (grid %d)\n", hipGetErrorString(e), grid);
}
```

```cpp
#include <hip/hip_runtime.h>
#include <hip/hip_cooperative_groups.h>
#include <cstdio>
#include <cstdint>
namespace cg = cooperative_groups;
#ifndef EPI2
#define EPI2 0
#endif
#ifndef DUPMASK
#define DUPMASK 0
#endif
#ifndef XSYNC
#define XSYNC 0
#endif

#define LAS __attribute__((address_space(3)))
typedef unsigned short bf16_t;
typedef short bf16x8 __attribute__((ext_vector_type(8)));
typedef float f32x4 __attribute__((ext_vector_type(4)));
typedef float f32x16 __attribute__((ext_vector_type(16)));
typedef unsigned u32x4 __attribute__((ext_vector_type(4)));
typedef unsigned u32x2 __attribute__((ext_vector_type(2)));
typedef float f32x2_t __attribute__((ext_vector_type(2)));
typedef __bf16 bf16x2_t __attribute__((ext_vector_type(2)));

__device__ __forceinline__ unsigned cvtpk(float lo, float hi) { f32x2_t v = {lo, hi}; bf16x2_t b = __builtin_convertvector(v, bf16x2_t); return __builtin_bit_cast(unsigned, b); }
__device__ __forceinline__ float bflo(unsigned w) { return __uint_as_float(w << 16); }
__device__ __forceinline__ float bfhi(unsigned w) { return __uint_as_float(w & 0xffff0000u); }

__device__ __forceinline__ int fresh_tid(int wave) { int l; asm volatile("v_mbcnt_lo_u32_b32 %0, -1, 0\n\tv_mbcnt_hi_u32_b32 %0, -1, %0" : "=v"(l)); return wave * 64 + l; }
template <int X> __device__ __forceinline__ float xshfl(float v) {
    if (X == 32) { auto rr = __builtin_amdgcn_permlane32_swap(__float_as_uint(v), __float_as_uint(v), false, false);
        const int l = __builtin_amdgcn_mbcnt_lo(~0u, 0u); (void)l; return 0.f; }
    return __uint_as_float((unsigned)__builtin_amdgcn_ds_swizzle((int)__float_as_uint(v), (X << 10) | 0x1f));
}
__device__ __forceinline__ float sum32(float v) { auto rr = __builtin_amdgcn_permlane32_swap(__float_as_uint(v), __float_as_uint(v), false, false); return __uint_as_float(rr[0]) + __uint_as_float(rr[1]); }
__device__ __forceinline__ float max32(float v) { auto rr = __builtin_amdgcn_permlane32_swap(__float_as_uint(v), __float_as_uint(v), false, false); return fmaxf(__uint_as_float(rr[0]), __uint_as_float(rr[1])); }

constexpr int DM = 1024, NB = 16, SEQ = 4096, NMETA = 16, FF = 4096;
constexpr int MREAL = NB * SEQ;
constexpr int MALL = MREAL + 256;
constexpr int NQKV = 1536;
constexpr float EPS = 1e-6f;
constexpr float LOG2E = 1.4426950408889634f;
constexpr int NCH = MREAL / 16;
constexpr int UXLD = 384;

constexpr size_t MiB = 1u << 20;
constexpr size_t WS_WQKV = 0, WS_WO = 3 * MiB, WS_WUP0 = 5 * MiB, WS_WDN0 = 13 * MiB, WS_WGLU = 21 * MiB, WS_WUP1 = 25 * MiB, WS_WDN1 = 33 * MiB;
constexpr size_t WS_BW1 = 41 * MiB, WS_BW2 = 49 * MiB, WS_A16 = 61 * MiB, WS_UM = 61 * MiB + 65536, WS_RS0 = 62 * MiB;
constexpr size_t WS_SS1 = 63 * MiB, WS_SS3 = 68 * MiB, WS_SS4 = 76 * MiB;
constexpr size_t WS_CTL = 81 * MiB;
constexpr size_t WS_RA = 82 * MiB, WS_RB = 211 * MiB, WS_RC = 340 * MiB;
constexpr size_t WS_Q = WS_RC, WS_K = WS_RC + 129 * MiB, WS_V = WS_RC + 162 * MiB;
constexpr size_t WS_ACT = WS_RC;
constexpr size_t WS_UX = WS_RC, WS_S = WS_RC + 192 * MiB, WS_Y = WS_RC + 320 * MiB;
constexpr size_t WS_END = WS_RC + 514 * MiB;

namespace pg8 {
constexpr int BM = 256, BK = 64, HALF = 128, HTB = HALF * BK * 2, STAGE_BYTES = 8 * HTB, NXCD = 8, WGM = 8;
__host__ __device__ __forceinline__ int lds_byte(int r, int c) { const int st = (r >> 4) * 2 + (c >> 5), rr = r & 15, cc = c & 31, ob = rr * 64 + cc * 2; return st * 1024 + (ob ^ (((ob >> 9) & 1) << 5)); }
__host__ __device__ __forceinline__ void stage_rc(int b, int& R, int& C) { const int st = b / 1024, sb = b % 1024, swz = sb ^ (((sb >> 9) & 1) << 5); R = (st >> 1) * 16 + swz / 64; C = (st & 1) * 32 + (swz % 64) / 2; }
__host__ __device__ __forceinline__ int perm32(int rho) { const int n = rho >> 4, i = rho & 15; return 8 * (i >> 2) + 4 * n + (i & 3); }

struct Unit { int pm, pn, pb; };
struct Gemm { const bf16_t* A; const bf16_t* Bt; int K, lda, ldb; size_t bsA, bsB; };

struct StaticOrder {
    int nM, nN, nwg, G, c;
    __device__ void init(int M, int N, int G_, int c_) { nM = M / BM; nN = N / BM; nwg = nM * nN; G = G_; c = c_; }
    __device__ bool next(int i, Unit& u) const {
        const long L = (long)i * G + c; if (L >= nwg) return false;
        int wgid = (int)L; { const int q = nwg / NXCD, r = nwg % NXCD, xcd = wgid % NXCD, off = wgid / NXCD; wgid = (xcd < r ? xcd * (q + 1) : r * (q + 1) + (xcd - r) * q) + off; }
        const int nig = WGM * nN, gid = wgid / nig, fm = gid * WGM, gsz = (nM - fm) < WGM ? (nM - fm) : WGM;
        u.pm = fm + ((wgid % nig) % gsz); u.pn = (wgid % nig) / gsz; u.pb = 0; return true;
    }
};
struct BatchOrder {
    int G, c;
    __device__ bool next(int i, Unit& u) const { const int L = i * G + c; if (L >= 64 * 16) return false; u.pb = L >> 4; u.pm = L & 15; u.pn = 0; return true; }
};

template <class Epi, class Sched>
__device__ __forceinline__ void gemm_phase(LAS unsigned char* lds, const Gemm g, const Sched& S, const Epi& E, int wave_, unsigned stag = 0) {
    if (stag > 7u) { const unsigned long long t0_ = __builtin_amdgcn_s_memrealtime(); const unsigned long long w_ = (unsigned long long)(blockIdx.x >> 3) * stag / 32;
        while (__builtin_amdgcn_s_memrealtime() - t0_ < w_) __builtin_amdgcn_s_sleep(8); }
    const int tid_ = fresh_tid(wave_);
    const int tid = tid_, wid = wave_, lane = tid & 63, wr = wid >> 2, wc = wid & 3, fr = lane & 15, fq = lane >> 4;
    const int K = g.K, nt = K / BK;
    unsigned voffA[2], voffB[2];
#pragma unroll
    for (int i = 0; i < 2; ++i) { int R, C; stage_rc(tid * 16 + i * 8192, R, C); const int Rb = (R & ~31) + perm32(R & 31);
        voffA[i] = (unsigned)(R * g.lda + C) * 2u; voffB[i] = (unsigned)(Rb * g.ldb + C) * 2u; }
    const size_t kstep = (size_t)(BK * 2);
    const size_t hA = (size_t)HALF * g.lda * 2, hB = (size_t)HALF * g.ldb * 2;
    const size_t tA = 2 * hA, tB = 2 * hB;
    const unsigned ldsw = (unsigned)wid * 1024u;
    const int aoff = lds_byte(wr * 64 + fr, fq * 8), boff = lds_byte(wc * 32 + fr, fq * 8);
#define PG8_SA(b, h) (((b) * 2 + (h)) * HTB)
#define PG8_SB(b, h) ((4 + (b) * 2 + (h)) * HTB)
#define PG8_STAGE(bufoff, gbase, voff) do { _Pragma("unroll") for (int _i = 0; _i < 2; ++_i) \
        __builtin_amdgcn_global_load_lds((const unsigned*)((const char*)(gbase) + (voff)[_i]), (LAS unsigned*)(lds + (bufoff) + ldsw + _i * 8192), 16, 0, 0); } while (0)
#define PG8_LDA(dst, b, h) do { _Pragma("unroll") for (int m = 0; m < 4; ++m) _Pragma("unroll") for (int k = 0; k < 2; ++k) dst[m][k] = *(const LAS bf16x8*)(lds + PG8_SA(b, h) + aoff + m * 2048 + k * 1024); } while (0)
#define PG8_LDB(dst, b, h) do { _Pragma("unroll") for (int n = 0; n < 2; ++n) _Pragma("unroll") for (int k = 0; k < 2; ++k) dst[n][k] = *(const LAS bf16x8*)(lds + PG8_SB(b, h) + boff + n * 2048 + k * 1024); } while (0)
#define PG8_MMA(ai, bj, At, Bt) do { __builtin_amdgcn_s_setprio(1); _Pragma("unroll") for (int m = 0; m < 4; ++m) _Pragma("unroll") for (int n = 0; n < 2; ++n) _Pragma("unroll") for (int k = 0; k < 2; ++k) \
        acc[ai][bj][m][n] = __builtin_amdgcn_mfma_f32_16x16x32_bf16(Bt[n][k], At[m][k], acc[ai][bj][m][n], 0, 0, 0); __builtin_amdgcn_s_setprio(0); } while (0)
#define PG8_WAIT_V(n) asm volatile("s_waitcnt vmcnt(" #n ")" ::: "memory")
#define PG8_WAIT_L(n) asm volatile("s_waitcnt lgkmcnt(" #n ")" ::: "memory")
#define PG8_BAR __builtin_amdgcn_s_barrier()
#define PG8_SCHED __builtin_amdgcn_sched_barrier(0)
    Unit cur, nxt; int ui = 0;
    if (!S.next(0, cur)) return;
    f32x4 acc[2][2][4][2];
#pragma unroll
    for (int a = 0; a < 2; ++a)
#pragma unroll
        for (int b = 0; b < 2; ++b)
#pragma unroll
            for (int m = 0; m < 4; ++m)
#pragma unroll
                for (int n = 0; n < 2; ++n) acc[a][b][m][n] = (f32x4){0.f, 0.f, 0.f, 0.f};
    bf16x8 At[4][2], B0[2][2], B1[2][2];
    const char* cA = (const char*)g.A + (size_t)cur.pb * g.bsA * 2 + (size_t)cur.pm * tA;
    const char* cB = (const char*)g.Bt + (size_t)cur.pb * g.bsB * 2 + (size_t)cur.pn * tB;
    PG8_STAGE(PG8_SB(0, 0), cB, voffB); PG8_STAGE(PG8_SB(0, 1), cB + hB, voffB); PG8_STAGE(PG8_SA(0, 0), cA, voffA); PG8_STAGE(PG8_SA(0, 1), cA + hA, voffA);
    if (wr == 1) PG8_BAR;
    PG8_WAIT_V(2); PG8_BAR;
    PG8_STAGE(PG8_SB(1, 0), cB + kstep, voffB); PG8_STAGE(PG8_SA(1, 0), cA + kstep, voffA); PG8_STAGE(PG8_SB(1, 1), cB + hB + kstep, voffB);
    PG8_WAIT_V(6); PG8_BAR;
    for (;;) {
        const bool has_next = S.next(ui + 1, nxt);
        const char* nA = has_next ? (const char*)g.A + (size_t)nxt.pb * g.bsA * 2 + (size_t)nxt.pm * tA : cA;
        const char* nB = has_next ? (const char*)g.Bt + (size_t)nxt.pb * g.bsB * 2 + (size_t)nxt.pn * tB : cB;
#pragma unroll 1
        for (int t = 0; t < nt; t += 2) {
            const bool last = (t == nt - 2);
            const char* a1 = cA + (size_t)(t + 1) * kstep;
            const char* a2 = last ? nA : cA + (size_t)(t + 2) * kstep; const char* b2 = last ? nB : cB + (size_t)(t + 2) * kstep;
            const char* a3 = a2 + kstep; const char* b3 = b2 + kstep;
            PG8_LDB(B0, 0, 0); PG8_LDB(B1, 0, 1); PG8_SCHED; PG8_LDA(At, 0, 0); PG8_STAGE(PG8_SA(1, 1), a1 + hA, voffA);
            PG8_WAIT_V(8); PG8_WAIT_L(0); PG8_BAR; PG8_MMA(0, 0, At, B0); PG8_MMA(0, 1, At, B1); PG8_BAR; PG8_SCHED;
            PG8_LDA(At, 0, 1); PG8_STAGE(PG8_SB(0, 0), b2, voffB); PG8_STAGE(PG8_SB(0, 1), b2 + hB, voffB); PG8_STAGE(PG8_SA(0, 0), a2, voffA);
            PG8_WAIT_V(8); PG8_WAIT_L(0); PG8_BAR; PG8_MMA(1, 0, At, B0); PG8_MMA(1, 1, At, B1); PG8_BAR; PG8_SCHED;
            PG8_LDB(B0, 1, 0); PG8_LDB(B1, 1, 1); PG8_SCHED; PG8_LDA(At, 1, 0); PG8_STAGE(PG8_SA(0, 1), a2 + hA, voffA);
            PG8_WAIT_V(8); PG8_WAIT_L(0); PG8_BAR; PG8_MMA(0, 0, At, B0); PG8_MMA(0, 1, At, B1); PG8_BAR; PG8_SCHED;
            PG8_LDA(At, 1, 1); PG8_STAGE(PG8_SB(1, 0), b3, voffB); PG8_STAGE(PG8_SB(1, 1), b3 + hB, voffB); PG8_STAGE(PG8_SA(1, 0), a3, voffA);
            PG8_WAIT_V(8); PG8_WAIT_L(0); PG8_BAR; PG8_MMA(1, 0, At, B0); PG8_MMA(1, 1, At, B1); PG8_BAR; PG8_SCHED;
        }
        if (wr == 0) PG8_BAR;
        E(acc, cur, wr, wc, fr, fq);
        if (EPI2 && stag == 7u) { asm volatile("" ::: "memory"); E(acc, cur, wr, wc, fr, fq); }
        if (!has_next) break;
#pragma unroll
        for (int a = 0; a < 2; ++a)
#pragma unroll
            for (int b = 0; b < 2; ++b)
#pragma unroll
                for (int m = 0; m < 4; ++m)
#pragma unroll
                    for (int n = 0; n < 2; ++n) acc[a][b][m][n] = (f32x4){0.f, 0.f, 0.f, 0.f};
        cur = nxt; cA = nA; cB = nB; ++ui;
        if (wr == 1) PG8_BAR;
    }
    PG8_WAIT_V(0);
    PG8_BAR;
#undef PG8_SA
#undef PG8_SB
#undef PG8_STAGE
#undef PG8_LDA
#undef PG8_LDB
#undef PG8_MMA
#undef PG8_WAIT_V
#undef PG8_WAIT_L
#undef PG8_BAR
#undef PG8_SCHED
}
}
using pg8::Unit;
typedef f32x4 AccT[2][2][4][2];
__device__ __forceinline__ float wave_sum(float v) {
    v += xshfl<1>(v); v += xshfl<2>(v); v += xshfl<4>(v); v += xshfl<8>(v); v += xshfl<16>(v); return sum32(v);
}


__device__ __forceinline__ u32x4 pack8(f32x4 v0, f32x4 v1) { u32x4 w; w.x = cvtpk(v0[0], v0[1]); w.y = cvtpk(v0[2], v0[3]); w.z = cvtpk(v1[0], v1[1]); w.w = cvtpk(v1[2], v1[3]); return w; }
__device__ __forceinline__ void unpack8(u32x4 w, f32x4& v0, f32x4& v1) { v0 = (f32x4){bflo(w.x), bfhi(w.x), bflo(w.y), bfhi(w.y)}; v1 = (f32x4){bflo(w.z), bfhi(w.z), bflo(w.w), bfhi(w.w)}; }

template <int NS> __device__ __forceinline__ float row_rs(const float* SS, int r, int fq) {
    float s;
    if (NS == 16) { const f32x4 a = *(const f32x4*)(SS + (size_t)r * 16 + fq * 4); s = (a[0] + a[1]) + (a[2] + a[3]); }
    else { const f32x4 a = *(const f32x4*)(SS + (size_t)r * 32 + fq * 8), b = *(const f32x4*)(SS + (size_t)r * 32 + fq * 8 + 4); s = ((a[0] + a[1]) + (a[2] + a[3])) + ((b[0] + b[1]) + (b[2] + b[3])); }
    s += xshfl<16>(s); s = sum32(s);
    return __builtin_amdgcn_rsqf(s * (1.0f / DM) + EPS);
}

struct XS { LAS u32x4* p; int lane; };
__device__ __forceinline__ void lane_tr2(const XS& x, int fr, int fq, u32x4& w0, u32x4& w1) {
    x.p[fr * 4 + fq] = w0; x.p[64 + fr * 4 + fq] = w1;
    w0 = x.p[x.lane]; w1 = x.p[64 + x.lane];
}
__device__ __forceinline__ void lane_tr1(const XS& x, int fr, int fq, u32x4& w0) { x.p[fr * 4 + fq] = w0; w0 = x.p[x.lane]; }
struct EpiQKV {
    bf16_t* Q; bf16_t* Kb; bf16_t* Vb; const float* rs; float qscale; XS xs;
    __device__ __forceinline__ void operator()(const AccT& acc, const Unit& u, int wr, int wc, int fr, int fq) const {
        const int row0 = u.pm * 256 + wr * 64 + fr;
        bf16_t* base; int ld, cb; float sc;
        if (u.pn < 4) { base = Q; ld = DM; cb = u.pn * 256; sc = qscale; } else if (u.pn == 4) { base = Kb; ld = 256; cb = 0; sc = 1.f; } else { base = Vb; ld = 256; cb = 0; sc = 1.f; }
        const int col0 = cb + wc * 32 + 8 * fq;
        float s[2][4];
#pragma unroll
        for (int ai = 0; ai < 2; ++ai)
#pragma unroll
            for (int m = 0; m < 4; ++m) s[ai][m] = rs[row0 + ai * 128 + m * 16] * sc;
        asm volatile("" ::: "memory");
#pragma unroll
        for (int ai = 0; ai < 2; ++ai)
#pragma unroll
            for (int m = 0; m < 4; ++m) { const int r = row0 - fr + (xs.lane >> 2) + ai * 128 + m * 16; bf16_t* rowp = base + (size_t)r * ld + cb + wc * 32 + 8 * (xs.lane & 3);
                u32x4 w0 = pack8(acc[ai][0][m][0] * s[ai][m], acc[ai][0][m][1] * s[ai][m]), w1 = pack8(acc[ai][1][m][0] * s[ai][m], acc[ai][1][m][1] * s[ai][m]);
                lane_tr2(xs, fr, fq, w0, w1); *(u32x4*)rowp = w0; *(u32x4*)(rowp + 128) = w1; }
    }
};
struct EpiResid {
    const bf16_t* Hin; bf16_t* Hout; float* SS; XS xs;
    __device__ __forceinline__ void operator()(const AccT& acc, const Unit& u, int wr, int wc, int fr, int fq) const {
        const int row0 = u.pm * 256 + wr * 64 + fr, col0 = u.pn * 256 + wc * 32 + 8 * fq;
        u32x4 hr[2][4][2];
#pragma unroll
        for (int ai = 0; ai < 2; ++ai)
#pragma unroll
            for (int m = 0; m < 4; ++m)
#pragma unroll
                for (int bj = 0; bj < 2; ++bj) hr[ai][m][bj] = *(const u32x4*)(Hin + (size_t)(row0 + ai * 128 + m * 16) * DM + col0 + bj * 128);
        asm volatile("" ::: "memory");
#pragma unroll
        for (int ai = 0; ai < 2; ++ai)
#pragma unroll
            for (int m = 0; m < 4; ++m) { const int r = row0 + ai * 128 + m * 16; float q = 0.f; u32x4 wv[2];
#pragma unroll
                for (int bj = 0; bj < 2; ++bj) { f32x4 h0, h1; unpack8(hr[ai][m][bj], h0, h1);
                    const f32x4 v0 = acc[ai][bj][m][0] + h0, v1 = acc[ai][bj][m][1] + h1;
                    q += (v0[0] * v0[0] + v0[1] * v0[1]) + (v0[2] * v0[2] + v0[3] * v0[3]) + (v1[0] * v1[0] + v1[1] * v1[1]) + (v1[2] * v1[2] + v1[3] * v1[3]);
                    wv[bj] = pack8(v0, v1); }
                lane_tr2(xs, fr, fq, wv[0], wv[1]);
                { bf16_t* op = Hout + (size_t)(r - fr + (xs.lane >> 2)) * DM + u.pn * 256 + wc * 32 + 8 * (xs.lane & 3); *(u32x4*)op = wv[0]; *(u32x4*)(op + 128) = wv[1]; }
                if (SS) { q += xshfl<16>(q); q = sum32(q); if (fq == 0) SS[(size_t)r * 16 + u.pn * 4 + wc] = q; } }
    }
};
template <int NS> struct EpiUp {
    const float* SS; bf16_t* ACT; XS xs;
    __device__ __forceinline__ void operator()(const AccT& acc, const Unit& u, int wr, int wc, int fr, int fq) const {
        const int row0 = u.pm * 256 + wr * 64 + fr, col0 = u.pn * 256 + wc * 32 + 8 * fq;
        float s[2][4];
#pragma unroll
        for (int ai = 0; ai < 2; ++ai)
#pragma unroll
            for (int m = 0; m < 4; ++m) { const int r = row0 + ai * 128 + m * 16;
                if (NS == 16) { const f32x4 a = *(const f32x4*)(SS + (size_t)r * 16 + fq * 4); s[ai][m] = (a[0] + a[1]) + (a[2] + a[3]); }
                else { const f32x4 a = *(const f32x4*)(SS + (size_t)r * 32 + fq * 8), b = *(const f32x4*)(SS + (size_t)r * 32 + fq * 8 + 4); s[ai][m] = ((a[0] + a[1]) + (a[2] + a[3])) + ((b[0] + b[1]) + (b[2] + b[3])); } }
        asm volatile("" ::: "memory");
#pragma unroll
        for (int ai = 0; ai < 2; ++ai)
#pragma unroll
            for (int m = 0; m < 4; ++m) { float t = s[ai][m]; t += xshfl<16>(t); t = sum32(t); s[ai][m] = __builtin_amdgcn_rsqf(t * (1.0f / DM) + EPS); }
#pragma unroll
        for (int ai = 0; ai < 2; ++ai)
#pragma unroll
            for (int m = 0; m < 4; ++m) { const int r = row0 - fr + (xs.lane >> 2) + ai * 128 + m * 16; const float sc = s[ai][m]; bf16_t* rowp = ACT + (size_t)r * FF + u.pn * 256 + wc * 32 + 8 * (xs.lane & 3); u32x4 wv[2];
#pragma unroll
                for (int bj = 0; bj < 2; ++bj) { f32x4 v0 = acc[ai][bj][m][0] * sc, v1 = acc[ai][bj][m][1] * sc;
#pragma unroll
                    for (int i = 0; i < 4; ++i) { const float a = fmaxf(v0[i], 0.f), b = fmaxf(v1[i], 0.f); v0[i] = a * a; v1[i] = b * b; }
                    wv[bj] = pack8(v0, v1); }
                lane_tr2(xs, fr, fq, wv[0], wv[1]); __builtin_nontemporal_store(wv[0], (u32x4*)rowp); __builtin_nontemporal_store(wv[1], (u32x4*)(rowp + 128)); }
    }
};
struct EpiS {
    bf16_t* S;
    __device__ __forceinline__ void operator()(const AccT& acc, const Unit& u, int wr, int wc, int fr, int fq) const {
        const int row0 = u.pm * 256 + wr * 64 + fr, col0 = wc * 32 + 8 * fq;
#pragma unroll
        for (int ai = 0; ai < 2; ++ai)
#pragma unroll
            for (int m = 0; m < 4; ++m) { const int r = row0 + ai * 128 + m * 16;
                *(u32x4*)(S + ((size_t)u.pb * NCH + r) * 128 + col0) = pack8(acc[ai][0][m][0], acc[ai][0][m][1]); }
    }
};
__device__ __forceinline__ float gelu_tanh(float x) { const float z = 0.7978845608028654f * (x + 0.044715f * x * x * x); return x * __builtin_amdgcn_rcpf(1.0f + __builtin_amdgcn_exp2f(-2.0f * LOG2E * z)); }
struct EpiY {
    const bf16_t* UX; const float* Dsk; bf16_t* Y; XS xs;
    __device__ __forceinline__ void operator()(const AccT& acc, const Unit& u, int wr, int wc, int fr, int fq) const {
        const int g = u.pb; const int r0 = u.pm * 256 + wr * 64 + fr; const int colb = wc * 32 + 8 * fq, c0 = colb & 15;
        const f32x4 d0 = *(const f32x4*)(Dsk + g * 16 + c0), d1 = *(const f32x4*)(Dsk + g * 16 + c0 + 4);
        const unsigned offU0 = (unsigned)(((size_t)g * NCH + r0) * UXLD + colb) * 2u;
        const int colb2 = wc * 32 + 8 * (xs.lane & 3);
        unsigned offY = (unsigned)(((size_t)(r0 - fr + (xs.lane >> 2)) * 16 + (colb2 >> 4)) * DM + g * 16 + (colb2 & 15)) * 2u;
        u32x4 ur[2][4][2];
#pragma unroll
        for (int ai = 0; ai < 2; ++ai)
#pragma unroll
            for (int m = 0; m < 4; ++m)
#pragma unroll
                for (int bj = 0; bj < 2; ++bj) ur[ai][m][bj] = *(const u32x4*)((const char*)UX + offU0 + (unsigned)((ai * 128 + m * 16) * UXLD * 2 + bj * 256));
        asm volatile("" ::: "memory");
#pragma unroll
        for (int ai = 0; ai < 2; ++ai)
#pragma unroll
            for (int m = 0; m < 4; ++m) {
                asm volatile("" : "+v"(offY)); u32x4 wv[2];
#pragma unroll
                for (int bj = 0; bj < 2; ++bj) {
                    const u32x4 uw = ur[ai][m][bj]; u32x4 ow;
                    { f32x4 v = acc[ai][bj][m][0] + d0 * (f32x4){bflo(uw.x), bfhi(uw.x), bflo(uw.y), bfhi(uw.y)};
#pragma unroll
                      for (int i = 0; i < 4; ++i) v[i] = gelu_tanh(v[i]);
                      ow.x = cvtpk(v[0], v[1]); ow.y = cvtpk(v[2], v[3]); }
                    { f32x4 v = acc[ai][bj][m][1] + d1 * (f32x4){bflo(uw.z), bfhi(uw.z), bflo(uw.w), bfhi(uw.w)};
#pragma unroll
                      for (int i = 0; i < 4; ++i) v[i] = gelu_tanh(v[i]);
                      ow.z = cvtpk(v[0], v[1]); ow.w = cvtpk(v[2], v[3]); }
                    wv[bj] = ow; }
                lane_tr2(xs, fr, fq, wv[0], wv[1]);
                *(u32x4*)((char*)Y + offY) = wv[0]; *(u32x4*)((char*)Y + offY + 8 * DM * 2) = wv[1];
                offY += (m == 3 ? 80 : 16) * 16 * DM * 2;
            }
    }
};
struct EpiGLU {
    const bf16_t* Hin; bf16_t* Hout; float* SS; XS xs;
    __device__ __forceinline__ void operator()(const AccT& acc, const Unit& u, int wr, int wc, int fr, int fq) const {
        const int row0 = u.pm * 256 + wr * 64 + fr, col0 = u.pn * 128 + wc * 32 + 8 * fq;
        u32x4 hr[2][4];
#pragma unroll
        for (int ai = 0; ai < 2; ++ai)
#pragma unroll
            for (int m = 0; m < 4; ++m) hr[ai][m] = *(const u32x4*)(Hin + (size_t)(row0 + ai * 128 + m * 16) * DM + col0);
        asm volatile("" ::: "memory");
#pragma unroll
        for (int ai = 0; ai < 2; ++ai)
#pragma unroll
            for (int m = 0; m < 4; ++m) { const int r = row0 + ai * 128 + m * 16; const size_t off = (size_t)r * DM + col0;
                f32x4 h0, h1; unpack8(hr[ai][m], h0, h1);
                f32x4 v0, v1;
#pragma unroll
                for (int i = 0; i < 4; ++i) {
                    v0[i] = h0[i] + acc[ai][0][m][0][i] * __builtin_amdgcn_rcpf(1.0f + __builtin_amdgcn_exp2f(-LOG2E * acc[ai][1][m][0][i]));
                    v1[i] = h1[i] + acc[ai][0][m][1][i] * __builtin_amdgcn_rcpf(1.0f + __builtin_amdgcn_exp2f(-LOG2E * acc[ai][1][m][1][i])); }
                float q = (v0[0] * v0[0] + v0[1] * v0[1]) + (v0[2] * v0[2] + v0[3] * v0[3]) + (v1[0] * v1[0] + v1[1] * v1[1]) + (v1[2] * v1[2] + v1[3] * v1[3]);
                { u32x4 w = pack8(v0, v1); lane_tr1(xs, fr, fq, w); *(u32x4*)(Hout + (size_t)(r - fr + (xs.lane >> 2)) * DM + u.pn * 128 + wc * 32 + 8 * (xs.lane & 3)) = w; }
                q += xshfl<16>(q); q = sum32(q); if (fq == 0) SS[(size_t)r * 32 + u.pn * 4 + wc] = q; (void)off; }
    }
};

struct Params {
    const float* x; const float* meta; const float* attn_nw; const float* wqkv; const float* sinks; const float* wo;
    const float* ssm_nw; const float* lre; const float* lim; const float* logdt; const float* bre; const float* bim; const float* cre; const float* cim; const float* dsk; const float* wglu;
    const float* mlp_nw; const float* wup; const float* wdn; const float* fnw;
    float* out; unsigned char* ws;
};


__device__ __forceinline__ void transpose_item(const float* W, int K, int N, bf16_t* WT, const float* kscale, bool glu, LAS float* scr, int item, int lane) {
    const int nblk = N / 32, kb = item / nblk, nb = item % nblk, k0 = 64 * kb, n0 = 32 * nb;
#pragma unroll 8
    for (int i = 0; i < 32; ++i) { const int kk = 2 * i + (lane >> 5); float v = W[(size_t)(k0 + kk) * N + n0 + (lane & 31)]; if (kscale) v *= kscale[k0 + kk]; scr[kk * 33 + (lane & 31)] = v; }
    asm volatile("s_waitcnt lgkmcnt(0)" ::: "memory");
    const int c = lane & 7;
#pragma unroll
    for (int j = 0; j < 4; ++j) { const int n = (lane >> 3) + 8 * j; const LAS float* s = scr + (8 * c) * 33 + n;
        u32x4 o; o.x = cvtpk(s[0 * 33], s[1 * 33]); o.y = cvtpk(s[2 * 33], s[3 * 33]); o.z = cvtpk(s[4 * 33], s[5 * 33]); o.w = cvtpk(s[6 * 33], s[7 * 33]);
        int nd = n0 + n; if (glu) { const int bj = nd >> 10, rem = nd & 1023; nd = (rem >> 7) * 256 + bj * 128 + (rem & 127); }
        *(u32x4*)(WT + (size_t)nd * K + k0 + 8 * c) = o; }
    asm volatile("s_waitcnt lgkmcnt(0)" ::: "memory");
}

struct SsmP { float lr, li, dt; };
__device__ __forceinline__ void cpow(const SsmP& s, float tau, float& re, float& im) { const float mag = expf(s.lr * s.dt * tau); float sn, cs; sincosf(s.li * s.dt * tau, &sn, &cs); re = mag * cs; im = mag * sn; }
__device__ __forceinline__ void ccoef(const SsmP& s, float& re, float& im) {
    float ar, ai; cpow(s, 1.0f, ar, ai); ar -= 1.0f; const float den = 1.0f / (s.lr * s.lr + s.li * s.li);
    re = (ar * s.lr + ai * s.li) * den; im = (ai * s.lr - ar * s.li) * den;
}

template <int MODE> __device__ __forceinline__ void meta_gemm(const bf16_t* A, int lda, const bf16_t* Wt, int N, int K, int gw, int NGW, int lane,
                                                              const float* rs0, bf16_t* o0, bf16_t* o1, bf16_t* o2, const bf16_t* hin) {
    float rsv = 1.0f;
    if (MODE == 2) {
        for (int r = 0; r < 16; ++r) { f32x4 v0, v1, v2, v3; const u32x4* hp = (const u32x4*)(A + (size_t)r * lda + lane * 16); unpack8(hp[0], v0, v1); unpack8(hp[1], v2, v3);
            float s = (v0[0] * v0[0] + v0[1] * v0[1]) + (v0[2] * v0[2] + v0[3] * v0[3]) + (v1[0] * v1[0] + v1[1] * v1[1]) + (v1[2] * v1[2] + v1[3] * v1[3])
                    + (v2[0] * v2[0] + v2[1] * v2[1]) + (v2[2] * v2[2] + v2[3] * v2[3]) + (v3[0] * v3[0] + v3[1] * v3[1]) + (v3[2] * v3[2] + v3[3] * v3[3]);
            s = wave_sum(s); if (lane == r) rsv = 1.0f / sqrtf(s * (1.0f / DM) + EPS); }
    }
    for (int n = gw; n < N; n += NGW) {
        float acc[16];
#pragma unroll
        for (int r = 0; r < 16; ++r) acc[r] = 0.f;
        for (int k0 = lane * 8; k0 < K; k0 += 512) {
            f32x4 w0, w1; unpack8(*(const u32x4*)(Wt + (size_t)n * K + k0), w0, w1);
#pragma unroll
            for (int r = 0; r < 16; ++r) { f32x4 a0, a1; unpack8(*(const u32x4*)(A + (size_t)r * lda + k0), a0, a1);
                acc[r] += (a0[0] * w0[0] + a0[1] * w0[1]) + (a0[2] * w0[2] + a0[3] * w0[3]) + (a1[0] * w1[0] + a1[1] * w1[1]) + (a1[2] * w1[2] + a1[3] * w1[3]); }
        }
        float v = 0.f;
#pragma unroll
        for (int r = 0; r < 16; ++r) { const float s = wave_sum(acc[r]); v = (lane == r) ? s : v; }
        if (lane < 16) { const size_t row = MREAL + lane;
            if (MODE == 0) { v *= rs0[row]; bf16_t* dst; if (n < 1024) { v *= 0.125f * LOG2E; dst = o0 + row * DM + n; } else if (n < 1280) dst = o1 + row * 256 + (n - 1024); else dst = o2 + row * 256 + (n - 1280);
                *dst = (bf16_t)(cvtpk(v, 0.f) & 0xffffu); }
            else if (MODE == 1 || MODE == 3) { v += bflo((unsigned)hin[row * DM + n]); o0[row * DM + n] = (bf16_t)(cvtpk(v, 0.f) & 0xffffu); }
            else { v = fmaxf(v * rsv, 0.f); v = v * v; o0[row * FF + n] = (bf16_t)(cvtpk(v, 0.f) & 0xffffu); }
        }
    }
}

constexpr int KS_LD = 72, VT_LD = 296, KS_BYTES = 288 * KS_LD * 2;
struct AttnUnit { int b, kvh, qb; bool meta; };
__device__ __forceinline__ AttnUnit attn_unit(int L) { AttnUnit u; u.meta = L >= 2048; u.b = 0; u.qb = 0; if (!u.meta) { u.b = L >> 7; u.kvh = (L >> 5) & 3; u.qb = L & 31; } else u.kvh = L - 2048; return u; }
__device__ __forceinline__ void attn_fetch(const AttnUnit& u, const bf16_t* Kb, const bf16_t* Vb, int i, u32x4& kv, u32x4& vv) {
    const int kk = i >> 3, ch = i & 7; long row = -1;
    if (kk < 256) { const int s = u.qb * 128 - 128 + kk; if (!u.meta && s >= 0) row = (long)u.b * SEQ + s; } else if (kk < 272) row = MREAL + (kk - 256);
    kv = (u32x4){0u, 0u, 0u, 0u}; vv = (u32x4){0u, 0u, 0u, 0u};
    if (row >= 0) { kv = *(const u32x4*)(Kb + row * 256 + u.kvh * 64 + ch * 8); vv = *(const u32x4*)(Vb + row * 256 + u.kvh * 64 + ch * 8); }
}
template <bool SLOW> __device__ __forceinline__ void attn_tile(const LAS bf16_t* Ks, const LAS bf16_t* Vt, bf16_t* qp, const bf16x8 (&qf)[4], int rt, int t0, bool meta, float slope, float sink, int q, int hi, int piq) {
    int qq = q - 8 * hi; asm volatile("" : "+v"(qq));
    const float cb0 = -slope * (float)(128 + qq);
    float tr[16];
#pragma unroll
    for (int r = 0; r < 16; ++r) tr[r] = slope * (float)((r & 7) + 16 * (r >> 3));
    f32x16 S[6];
#pragma unroll
    for (int k6 = 0; k6 < 6; ++k6) { const int kt = (k6 < 5) ? rt + k6 : 8; const float c0 = (k6 < 5) ? cb0 + slope * (float)(32 * k6) : 0.f;
        f32x16 a;
#pragma unroll
        for (int r = 0; r < 16; ++r) a[r] = (k6 < 5) ? c0 + tr[r] : 0.f;
        const LAS bf16_t* kp = Ks + (32 * kt + piq) * KS_LD + hi * 8;
#pragma unroll
        for (int dk = 0; dk < 4; ++dk) a = __builtin_amdgcn_mfma_f32_32x32x16_bf16(*(const LAS bf16x8*)(kp + dk * 16), qf[dk], a, 0, 0, 0);
        S[k6] = a; asm volatile("" ::: "memory"); }
    float mx = sink;
    if (!SLOW) {
#pragma unroll
        for (int k6 = 0; k6 < 5; ++k6)
#pragma unroll
            for (int r = 0; r < 16; ++r) { const int kc = (r & 7) + 16 * (r >> 3); float v = S[k6][r];
                if (k6 == 0) v = (kc > qq) ? v : -1e30f;
                if (k6 == 4) v = (kc <= qq) ? v : -1e30f;
                S[k6][r] = v; mx = fmaxf(mx, v); }
#pragma unroll
        for (int r = 0; r < 8; ++r) mx = fmaxf(mx, S[5][r]);
    } else {
        const unsigned lim1 = meta ? 0u : (unsigned)min(128, t0 + 32 * rt + q + 1);
        const int qlim = meta ? q : 15;
#pragma unroll
        for (int k6 = 0; k6 < 6; ++k6)
#pragma unroll
            for (int r = 0; r < ((k6 < 5) ? 16 : 8); ++r) { const int kc = (r & 7) + 16 * (r >> 3); bool ok; float v;
                if (k6 < 5) { const int dist = 128 + qq - 32 * k6 - kc; ok = (unsigned)dist < lim1; v = S[k6][r]; }
                else { ok = (kc + 8 * hi) <= qlim; v = S[k6][r]; }
                v = ok ? v : -1e30f; S[k6][r] = v; mx = fmaxf(mx, v); }
    }
    mx = max32(mx);
    float l = 0.f;
#pragma unroll
    for (int k6 = 0; k6 < 6; ++k6)
#pragma unroll
        for (int r = 0; r < ((k6 < 5) ? 16 : 8); ++r) { const float p = __builtin_amdgcn_exp2f(S[k6][r] - mx); S[k6][r] = p; l += p; }
    l = sum32(l); l += __builtin_amdgcn_exp2f(sink - mx);
    f32x16 O[2]; O[0] = f32x16{}; O[1] = f32x16{};
#pragma unroll
    for (int k6 = 0; k6 < 6; ++k6) { const int kt = (k6 < 5) ? rt + k6 : 8;
#pragma unroll
        for (int hf = 0; hf < ((k6 < 5) ? 2 : 1); ++hf) {
            u32x4 pw; pw.x = cvtpk(S[k6][8 * hf + 0], S[k6][8 * hf + 1]); pw.y = cvtpk(S[k6][8 * hf + 2], S[k6][8 * hf + 3]); pw.z = cvtpk(S[k6][8 * hf + 4], S[k6][8 * hf + 5]); pw.w = cvtpk(S[k6][8 * hf + 6], S[k6][8 * hf + 7]);
            const bf16x8 pb = __builtin_bit_cast(bf16x8, pw);
#pragma unroll
            for (int dt = 0; dt < 2; ++dt) { const bf16x8 va = *(const LAS bf16x8*)(Vt + (32 * dt + q) * VT_LD + 32 * kt + 16 * hf + 8 * hi);
                O[dt] = __builtin_amdgcn_mfma_f32_32x32x16_bf16(va, pb, O[dt], 0, 0, 0); }
            asm volatile("" ::: "memory"); } }
    const float rl = 1.0f / l;
#pragma unroll
    for (int dt = 0; dt < 2; ++dt)
#pragma unroll
        for (int j = 0; j < 4; ++j) { u32x2 w; w.x = cvtpk(O[dt][4 * j] * rl, O[dt][4 * j + 1] * rl); w.y = cvtpk(O[dt][4 * j + 2] * rl, O[dt][4 * j + 3] * rl);
            if (!meta || q < 16) *(u32x2*)(qp + 32 * dt + 8 * j + 4 * hi) = w; }
}
__device__ __forceinline__ void attn_phase(LAS unsigned char* lds, bf16_t* Q, const bf16_t* Kb, const bf16_t* Vb, const float* sinks, int vcu, int G, int wave_) {
    const int tid_ = fresh_tid(wave_);
    const int tid = tid_, lane = tid & 63, wid = wave_, q = lane & 31, hi = lane >> 5;
    LAS bf16_t* Ks = (LAS bf16_t*)lds; LAS bf16_t* Vt = (LAS bf16_t*)(lds + KS_BYTES);
    const int piq = (q & 0x13) | ((q & 4) << 1) | ((q & 8) >> 1);
#pragma unroll 1
    for (int L = vcu; L < 2052; L += G) {
        const AttnUnit u = attn_unit(L);
        const bool meta = u.meta; const int b = u.b, kvh = u.kvh, qb = u.qb, t0 = qb * 128;
        __syncthreads();
        {
            int tl = tid; asm volatile("" : "+v"(tl));
            u32x4 pk[5], pv[5];
#pragma unroll
            for (int it = 0; it < 5; ++it) { const int i = tl + 512 * it; if (i < 288 * 8) attn_fetch(u, Kb, Vb, i, pk[it], pv[it]); }
#pragma unroll
            for (int it = 0; it < 5; ++it) { const int i = tl + 512 * it;
                if (i < 288 * 8) { const int kk = i >> 3, ch = i & 7; const u32x4 kv = pk[it], vv = pv[it];
                    *(LAS u32x4*)(Ks + kk * KS_LD + ch * 8) = kv;
                    LAS bf16_t* vp = Vt + (ch * 8) * VT_LD + kk;
                    vp[0 * VT_LD] = (bf16_t)(vv.x & 0xffffu); vp[1 * VT_LD] = (bf16_t)(vv.x >> 16); vp[2 * VT_LD] = (bf16_t)(vv.y & 0xffffu); vp[3 * VT_LD] = (bf16_t)(vv.y >> 16);
                    vp[4 * VT_LD] = (bf16_t)(vv.z & 0xffffu); vp[5 * VT_LD] = (bf16_t)(vv.z >> 16); vp[6 * VT_LD] = (bf16_t)(vv.w & 0xffffu); vp[7 * VT_LD] = (bf16_t)(vv.w >> 16); } }
        }
        const int hq = kvh * 4 + (wid >> 1);
        bf16x8 qf[4], qn[4];
        const int rt0 = (wid & 1) * 2; const long qrow0 = meta ? (long)(MREAL + q) : (long)b * SEQ + t0 + 32 * rt0 + q;
        bf16_t* qp0 = Q + qrow0 * DM + hq * 64; bf16_t* qp1 = qp0 + (meta ? 0 : 32 * DM);
#pragma unroll
        for (int dk = 0; dk < 4; ++dk) { qf[dk] = *(const bf16x8*)(qp0 + dk * 16 + hi * 8); qn[dk] = *(const bf16x8*)(qp1 + dk * 16 + hi * 8); }
        __syncthreads();
        const float slope = exp2f(-0.5f * (float)(hq + 1)) * LOG2E, sink = sinks[hq] * LOG2E;
        if (meta || qb == 0) {
            if (!meta || rt0 == 0) attn_tile<true>(Ks, Vt, qp0, qf, rt0, t0, meta, slope, sink, q, hi, piq);
            if (!meta) { asm volatile("" ::: "memory"); attn_tile<true>(Ks, Vt, qp1, qn, rt0 + 1, t0, meta, slope, sink, q, hi, piq); }
        } else {
            attn_tile<false>(Ks, Vt, qp0, qf, rt0, t0, false, slope, sink, q, hi, piq);
            asm volatile("" ::: "memory");
            attn_tile<false>(Ks, Vt, qp1, qn, rt0 + 1, t0, false, slope, sink, q, hi, piq);
        }
    }
    __syncthreads();
}

#define XB_TMO      128
#define XB_XCNT(j)  (256  + 64 * (j))
#define XB_XSUB(j)  (1280 + 64 * (j))
#define XB_XGEN(j)  (2304 + 64 * (j))
#define XB_TOP      3328
#define XB_TOPGEN   3392
#define XCD_BAR_WORDS 3456
#define XB_SPIN_CAP (1u << 18)
__device__ __forceinline__ unsigned xb_ld(unsigned* p)              { return __hip_atomic_load(p, __ATOMIC_RELAXED, __HIP_MEMORY_SCOPE_AGENT); }
__device__ __forceinline__ unsigned xb_add(unsigned* p, unsigned v) { return __hip_atomic_fetch_add(p, v, __ATOMIC_RELAXED, __HIP_MEMORY_SCOPE_AGENT); }
__device__ __forceinline__ unsigned xb_xcc_id() { return (unsigned)__builtin_amdgcn_s_getreg((3 << 11) | 20) & 0xFu; }
#define XB_SPIN(cond, bar) do { unsigned _sp = 0; while (cond) { __builtin_amdgcn_s_sleep(1); \
    if ((++_sp & 255u) == 0u) { if (xb_ld(&(bar)[XB_TMO])) break; if (_sp > XB_SPIN_CAP) { atomicAdd(&(bar)[XB_TMO], 1u); break; } } } } while (0)
struct XcdBarrier { unsigned* bar; unsigned x; volatile LAS unsigned* st; };
__device__ __forceinline__ XcdBarrier xcd_barrier_post(unsigned* bar, volatile LAS unsigned* st) {
    XcdBarrier b; b.bar = bar; b.x = xb_xcc_id(); b.st = st;
    if (threadIdx.x == 0) (void)xb_add(&bar[XB_XCNT(b.x)], 1u);
    return b;
}
__device__ __forceinline__ void xcd_barrier_complete(unsigned* bar, unsigned x, unsigned& nloc, unsigned& nx) {
    const unsigned G = gridDim.x * gridDim.y * gridDim.z;
    unsigned sum, cnt, mine, sp = 0u;
    for (;;) {
        sum = 0u; cnt = 0u; mine = 0u;
#pragma unroll
        for (unsigned j = 0; j < 16; ++j) { const unsigned c = xb_ld(&bar[XB_XCNT(j)]); sum += c; cnt += (c > 0u) ? 1u : 0u; mine = (j == x) ? c : mine; }
        if (sum == G) break;
        __builtin_amdgcn_s_sleep(1);
        if ((++sp & 255u) == 0u) { if (xb_ld(&bar[XB_TMO])) break; if (sp > XB_SPIN_CAP) { atomicAdd(&bar[XB_TMO], 1u); break; } }
    }
    nloc = mine > 0u ? mine : 1u; nx = cnt > 0u ? cnt : 1u;
}
__device__ __forceinline__ void xcd_barrier(const XcdBarrier& b) {
    asm volatile("s_waitcnt vmcnt(0)" ::: "memory");
    __syncthreads();
    if (threadIdx.x == 0) {
        unsigned* bar = b.bar;
        __builtin_amdgcn_s_waitcnt(0);
        unsigned nloc = b.st[0], nx = b.st[1];
        if (nloc == 0u) { xcd_barrier_complete(bar, b.x, nloc, nx); b.st[0] = nloc; b.st[1] = nx; }
        const unsigned old = xb_add(&bar[XB_XSUB(b.x)], 1u);
        const unsigned gen = old / nloc;
        if (old + 1u == (gen + 1u) * nloc) {
            __builtin_amdgcn_fence(__ATOMIC_RELEASE, "agent");
            asm volatile("s_waitcnt vmcnt(0)" ::: "memory");
            const unsigned og = xb_add(&bar[XB_TOP], 1u);
            const unsigned tg = og / nx;
            if (og + 1u == (tg + 1u) * nx) xb_add(&bar[XB_TOPGEN], 1u);
            else XB_SPIN(xb_ld(&bar[XB_TOPGEN]) == tg, bar);
            __builtin_amdgcn_fence(__ATOMIC_ACQUIRE, "agent");
            xb_add(&bar[XB_XGEN(b.x)], 1u);
            asm volatile("s_waitcnt vmcnt(0)" ::: "memory");
        } else {
            XB_SPIN(xb_ld(&bar[XB_XGEN(b.x)]) == gen, bar);
            __builtin_amdgcn_fence(__ATOMIC_ACQUIRE, "agent");
            asm volatile("s_waitcnt vmcnt(0)" ::: "memory");
        }
    }
    __syncthreads();
}

constexpr int LDS_BYTES = 151552;
#ifndef PHMASK
#define PHMASK 0xFFFF
#endif
#ifndef STAG_UP
#define STAG_UP 0
#endif
#define REP(k) for (int rep_ = 0; rep_ < ((DUPMASK >> (k)) & 1) + 1; ++rep_)
__global__ void __launch_bounds__(512, 2) fwd_kernel(Params P) {
    extern __shared__ __attribute__((aligned(16))) unsigned char lds_raw[];
    LAS unsigned char* lds = (LAS unsigned char*)lds_raw;
    cg::grid_group grid = cg::this_grid();
    const int wave = __builtin_amdgcn_readfirstlane((int)threadIdx.x >> 6);
    const int G = gridDim.x, bx = blockIdx.x;
    const int vcu = (G % 8 == 0) ? (bx % 8) * (G / 8) + bx / 8 : bx;
    const int gw = vcu * 8 + wave, NGW = G * 8;
    unsigned char* ws = P.ws;
#define mkxs() (XS{(LAS u32x4*)(lds + 132096 + wave * 2048), fresh_tid(wave) & 63})
    volatile LAS unsigned* bst = (volatile LAS unsigned*)(lds + 131072);
    if (threadIdx.x < 2) bst[threadIdx.x] = 0u;
    __syncthreads();
    const XcdBarrier xbar = xcd_barrier_post((unsigned*)(ws + WS_CTL), bst);
    bf16_t* Wqkv_t = (bf16_t*)(ws + WS_WQKV); bf16_t* Wo_t = (bf16_t*)(ws + WS_WO); bf16_t* Wup0_t = (bf16_t*)(ws + WS_WUP0); bf16_t* Wdn0_t = (bf16_t*)(ws + WS_WDN0);
    bf16_t* Wglu_t = (bf16_t*)(ws + WS_WGLU); bf16_t* Wup1_t = (bf16_t*)(ws + WS_WUP1); bf16_t* Wdn1_t = (bf16_t*)(ws + WS_WDN1);
    bf16_t* BW1 = (bf16_t*)(ws + WS_BW1); bf16_t* BW2 = (bf16_t*)(ws + WS_BW2); float* A16 = (float*)(ws + WS_A16); bf16_t* UM = (bf16_t*)(ws + WS_UM);
    float* RS0 = (float*)(ws + WS_RS0); float* SS1 = (float*)(ws + WS_SS1); float* SS3 = (float*)(ws + WS_SS3); float* SS4 = (float*)(ws + WS_SS4);
    bf16_t* HA = (bf16_t*)(ws + WS_RA); bf16_t* HB = (bf16_t*)(ws + WS_RB);
    bf16_t* Qb = (bf16_t*)(ws + WS_Q); bf16_t* Kb = (bf16_t*)(ws + WS_K); bf16_t* Vb = (bf16_t*)(ws + WS_V); bf16_t* ACT = (bf16_t*)(ws + WS_ACT);
    bf16_t* UX = (bf16_t*)(ws + WS_UX); bf16_t* Sst = (bf16_t*)(ws + WS_S); bf16_t* Yb = (bf16_t*)(ws + WS_Y);

    REP(0) if (PHMASK & 1) {
        const int t_ = fresh_tid(wave); const int tid = t_, lane = tid & 63; (void)tid; (void)lane;
        LAS float* scr = (LAS float*)(lds + wave * 16384);
        constexpr int I_QKV = 16 * 48, I_O = 16 * 32, I_UP = 16 * 128, I_DN = 64 * 32, I_GLU = 16 * 64;
        constexpr int NITEMS = I_QKV + I_O + 2 * I_UP + 2 * I_DN + I_GLU;
        for (int it = gw; it < NITEMS; it += NGW) {
            int r = it;
            if (r < I_QKV) { transpose_item(P.wqkv, DM, NQKV, Wqkv_t, P.attn_nw, false, scr, r, lane); continue; } r -= I_QKV;
            if (r < I_O) { transpose_item(P.wo, DM, DM, Wo_t, nullptr, false, scr, r, lane); continue; } r -= I_O;
            if (r < I_UP) { transpose_item(P.wup, DM, FF, Wup0_t, P.mlp_nw, false, scr, r, lane); continue; } r -= I_UP;
            if (r < I_DN) { transpose_item(P.wdn, FF, DM, Wdn0_t, nullptr, false, scr, r, lane); continue; } r -= I_DN;
            if (r < I_GLU) { transpose_item(P.wglu, DM, 2 * DM, Wglu_t, nullptr, true, scr, r, lane); continue; } r -= I_GLU;
            if (r < I_UP) { transpose_item(P.wup + (size_t)DM * FF, DM, FF, Wup1_t, P.mlp_nw + DM, false, scr, r, lane); continue; } r -= I_UP;
            transpose_item(P.wdn + (size_t)FF * DM, FF, DM, Wdn1_t, nullptr, false, scr, r, lane);
        }
        for (int m = gw; m < MREAL + NMETA; m += NGW) {
            unsigned long long* o8 = (unsigned long long*)(HA + (size_t)m * DM) + lane;
            const float* src = (m < MREAL) ? P.x + (size_t)m * DM : P.meta + (size_t)(m - MREAL) * DM;
            const f32x4* xr = (const f32x4*)src + lane; f32x4 v[4]; float s = 0.f;
#pragma unroll
            for (int j = 0; j < 4; ++j) { v[j] = xr[64 * j]; s += (v[j].x * v[j].x + v[j].y * v[j].y) + (v[j].z * v[j].z + v[j].w * v[j].w); }
            s = wave_sum(s);
#pragma unroll
            for (int j = 0; j < 4; ++j) o8[64 * j] = (unsigned long long)cvtpk(v[j].x, v[j].y) | ((unsigned long long)cvtpk(v[j].z, v[j].w) << 32);
            if (lane == 0) RS0[m] = 1.0f / sqrtf(s * (1.0f / DM) + EPS);
        }
        __syncthreads();
        {
            LAS float* AP = (LAS float*)lds;
            LAS float* BB = AP + 17 * 64 * 2;
            LAS float* CC = BB + 64 * 16 * 2;
            LAS float* KT = CC + 16 * 64 * 2;
            for (int item = vcu; item < 256; item += G) {
                const int g = item >> 2, qd = item & 3;
                const float dt = expf(P.logdt[g]);
                for (int idx = tid; idx < 17 * 64; idx += 512) { const int tau = idx >> 6, p = idx & 63;
                    SsmP s; s.lr = fminf(P.lre[g * 64 + p], -1e-4f); s.li = P.lim[g * 64 + p]; s.dt = dt; float ar, ai; cpow(s, (float)tau, ar, ai); AP[idx * 2] = ar; AP[idx * 2 + 1] = ai; }
                for (int idx = tid; idx < 64 * 16; idx += 512) { const int p = idx >> 4;
                    SsmP s; s.lr = fminf(P.lre[g * 64 + p], -1e-4f); s.li = P.lim[g * 64 + p]; s.dt = dt; float cr, ci; ccoef(s, cr, ci);
                    const float br = P.bre[g * 1024 + idx], bi = P.bim[g * 1024 + idx]; BB[idx * 2] = cr * br - ci * bi; BB[idx * 2 + 1] = cr * bi + ci * br; }
                for (int idx = tid; idx < 16 * 64; idx += 512) { CC[idx * 2] = P.cre[g * 1024 + idx]; CC[idx * 2 + 1] = P.cim[g * 1024 + idx]; }
                __syncthreads();
                for (int idx = tid; idx < 4096; idx += 512) { const int tau = idx >> 8, c = (idx >> 4) & 15, cp = idx & 15; float k = 0.f;
                    for (int p = 0; p < 64; ++p) { const float ar = AP[(tau * 64 + p) * 2], ai = AP[(tau * 64 + p) * 2 + 1], br = BB[(p * 16 + cp) * 2], bi = BB[(p * 16 + cp) * 2 + 1];
                        k += CC[(c * 64 + p) * 2] * (ar * br - ai * bi) - CC[(c * 64 + p) * 2 + 1] * (ar * bi + ai * br); }
                    KT[idx] = k; }
                __syncthreads();
                for (int idx = tid; idx < 64 * 32; idx += 512) { const int n = qd * 64 + (idx >> 5), k0 = (idx & 31) * 8, ti = n >> 4, c = n & 15, si = k0 >> 4, cp0 = k0 & 15;
                    u32x4 w = (u32x4){0u, 0u, 0u, 0u};
                    if (si <= ti) { const LAS float* kp = KT + ((ti - si) * 16 + c) * 16 + cp0; w.x = cvtpk(kp[0], kp[1]); w.y = cvtpk(kp[2], kp[3]); w.z = cvtpk(kp[4], kp[5]); w.w = cvtpk(kp[6], kp[7]); }
                    *(u32x4*)(BW2 + ((size_t)g * 256 + n) * UXLD + k0) = w; }
                for (int idx = tid; idx < 64 * 16; idx += 512) { const int n = qd * 64 + (idx >> 4), p0 = (idx & 15) * 4, ti = n >> 4, c = n & 15; unsigned w[4];
#pragma unroll
                    for (int j = 0; j < 4; ++j) { const int p = p0 + j; const float cr = CC[(c * 64 + p) * 2], ci = CC[(c * 64 + p) * 2 + 1], ar = AP[((ti + 1) * 64 + p) * 2], ai = AP[((ti + 1) * 64 + p) * 2 + 1];
                        w[j] = cvtpk(cr * ar - ci * ai, -(cr * ai + ci * ar)); }
                    *(u32x4*)(BW2 + ((size_t)g * 256 + n) * UXLD + 256 + 2 * p0) = (u32x4){w[0], w[1], w[2], w[3]}; }
                for (int idx = tid; idx < 16 * 32; idx += 512) { const int p = qd * 16 + (idx >> 5), k0 = (idx & 31) * 8, si = k0 >> 4, cp0 = k0 & 15;
                    const float ar = AP[((15 - si) * 64 + p) * 2], ai = AP[((15 - si) * 64 + p) * 2 + 1]; float re[8], im[8];
#pragma unroll
                    for (int j = 0; j < 8; ++j) { const float br = BB[(p * 16 + cp0 + j) * 2], bi = BB[(p * 16 + cp0 + j) * 2 + 1]; re[j] = ar * br - ai * bi; im[j] = ar * bi + ai * br; }
                    *(u32x4*)(BW1 + ((size_t)g * 256 + 2 * p) * 256 + k0) = (u32x4){cvtpk(re[0], re[1]), cvtpk(re[2], re[3]), cvtpk(re[4], re[5]), cvtpk(re[6], re[7])};
                    *(u32x4*)(BW1 + ((size_t)g * 256 + 2 * p + 1) * 256 + k0) = (u32x4){cvtpk(im[0], im[1]), cvtpk(im[2], im[3]), cvtpk(im[4], im[5]), cvtpk(im[6], im[7])}; }
                for (int idx = tid; idx < 32 * 32; idx += 512) { const int n = 128 + qd * 32 + (idx >> 5), k0 = (idx & 31) * 8;
                    *(u32x4*)(BW1 + ((size_t)g * 256 + n) * 256 + k0) = (u32x4){0u, 0u, 0u, 0u}; }
                if (qd == 0 && tid < 64) { A16[2 * (g * 64 + tid)] = AP[(16 * 64 + tid) * 2]; A16[2 * (g * 64 + tid) + 1] = AP[(16 * 64 + tid) * 2 + 1]; }
                __syncthreads();
            }
        }
    }
    if (gridDim.y == 0x7fffffffu) grid.sync();
    xcd_barrier(xbar);

    REP(1) if (PHMASK & (1 << 1)) {
        pg8::Gemm g{HA, Wqkv_t, DM, DM, DM, 0, 0}; pg8::StaticOrder S; S.init(MREAL, NQKV, G, bx);
        EpiQKV E{Qb, Kb, Vb, RS0, 0.125f * LOG2E, mkxs()};
        pg8::gemm_phase(lds, g, S, E, wave);
        { const int t_ = fresh_tid(wave); meta_gemm<0>(HA + (size_t)MREAL * DM, DM, Wqkv_t, NQKV, DM, gw, NGW, t_ & 63, RS0, Qb, Kb, Vb, nullptr); }
    }
    xcd_barrier(xbar);
    if (PHMASK & 4) attn_phase(lds, Qb, Kb, Vb, P.sinks, vcu, G, wave);
    xcd_barrier(xbar);
    REP(3) if (PHMASK & (1 << 3)) {
        pg8::Gemm g{Qb, Wo_t, DM, DM, DM, 0, 0}; pg8::StaticOrder S; S.init(MREAL, DM, G, bx);
        EpiResid E{HA, HB, SS1, mkxs()};
        pg8::gemm_phase(lds, g, S, E, wave);
        { const int t_ = fresh_tid(wave); meta_gemm<1>(Qb + (size_t)MREAL * DM, DM, Wo_t, DM, DM, gw, NGW, t_ & 63, nullptr, HB, nullptr, nullptr, HA); }
    }
    xcd_barrier(xbar);
    REP(4) if (PHMASK & (1 << 4)) {
        pg8::Gemm g{HB, Wup0_t, DM, DM, DM, 0, 0}; pg8::StaticOrder S; S.init(MREAL, FF, G, bx);
        EpiUp<16> E{SS1, ACT, mkxs()};
        pg8::gemm_phase(lds, g, S, E, wave, STAG_UP);
        { const int t_ = fresh_tid(wave); meta_gemm<2>(HB + (size_t)MREAL * DM, DM, Wup0_t, FF, DM, gw, NGW, t_ & 63, nullptr, ACT, nullptr, nullptr, nullptr); }
    }
    xcd_barrier(xbar);
    REP(5) if (PHMASK & (1 << 5)) {
        pg8::Gemm g{ACT, Wdn0_t, FF, FF, FF, 0, 0}; pg8::StaticOrder S; S.init(MREAL, DM, G, bx);
        EpiResid E{HB, HA, nullptr, mkxs()};
        pg8::gemm_phase(lds, g, S, E, wave);
        { const int t_ = fresh_tid(wave); meta_gemm<3>(ACT + (size_t)MREAL * FF, FF, Wdn0_t, DM, FF, gw, NGW, t_ & 63, nullptr, HA, nullptr, nullptr, HB); }
    }
    xcd_barrier(xbar);
    REP(6) if (PHMASK & (1 << 6)) {
        const int t_ = fresh_tid(wave); const int tid = t_, lane = tid & 63; (void)tid; (void)lane;
        f32x4 wv[4];
#pragma unroll
        for (int j = 0; j < 4; ++j) wv[j] = *(const f32x4*)(P.ssm_nw + lane * 16 + 4 * j);
        for (int ch = gw; ch < NCH + 1; ch += NGW) {
            const bool mt = ch == NCH;
            for (int ti = 0; ti < 16; ++ti) {
                const size_t row = mt ? (size_t)(MREAL + ti) : (size_t)ch * 16 + ti;
                const u32x4* hp = (const u32x4*)(HA + row * DM + lane * 16);
                f32x4 v[4]; unpack8(hp[0], v[0], v[1]); unpack8(hp[1], v[2], v[3]);
                float s = 0.f;
#pragma unroll
                for (int j = 0; j < 4; ++j) s += (v[j].x * v[j].x + v[j].y * v[j].y) + (v[j].z * v[j].z + v[j].w * v[j].w);
                s = wave_sum(s); const float rs = 1.0f / sqrtf(s * (1.0f / DM) + EPS);
#pragma unroll
                for (int j = 0; j < 4; ++j) v[j] = v[j] * rs * wv[j];
                bf16_t* dst = mt ? UM + lane * 256 + ti * 16 : UX + ((size_t)lane * NCH + ch) * UXLD + ti * 16;
                *(u32x4*)dst = pack8(v[0], v[1]); *(u32x4*)(dst + 8) = pack8(v[2], v[3]);
            }
        }
    }
    xcd_barrier(xbar);
    REP(7) if (PHMASK & (1 << 7)) {
        pg8::Gemm g{UX, BW1, 256, UXLD, 256, (size_t)NCH * UXLD, (size_t)256 * 256}; pg8::BatchOrder S{G, bx};
        EpiS E{Sst};
        pg8::gemm_phase(lds, g, S, E, wave);
    }
    xcd_barrier(xbar);
    REP(8) if (PHMASK & 256) {
        const int t_ = fresh_tid(wave); const int tid = t_, lane = tid & 63; (void)tid; (void)lane;
      if (tid < 256) {
        for (int item = bx * 256 + tid; item < NB * 64 * 64; item += G * 256) {
            const int p = item & 63, g = (item >> 6) & 63, b = item >> 12;
            const float ar = A16[2 * (g * 64 + p)], ai = A16[2 * (g * 64 + p) + 1];
            float xr = 0.f, xi = 0.f;
            { const bf16_t* um = UM + g * 256; const bf16_t* w0 = BW1 + ((size_t)g * 256 + 2 * p) * 256; const bf16_t* w1 = w0 + 256;
                for (int k = 0; k < 256; k += 8) { f32x4 u0, u1, a0, a1, b0, b1; unpack8(*(const u32x4*)(um + k), u0, u1); unpack8(*(const u32x4*)(w0 + k), a0, a1); unpack8(*(const u32x4*)(w1 + k), b0, b1);
#pragma unroll
                    for (int i = 0; i < 4; ++i) { xr += u0[i] * a0[i] + u1[i] * a1[i]; xi += u0[i] * b0[i] + u1[i] * b1[i]; } } }
            const bf16_t* sp = Sst + ((size_t)g * NCH + b * 256) * 128 + 2 * p;
            bf16_t* xp = UX + ((size_t)g * NCH + b * 256) * UXLD + 256 + 2 * p;
            for (int j0 = 0; j0 < 256; j0 += 16) {
                unsigned sv[16];
#pragma unroll
                for (int j = 0; j < 16; ++j) sv[j] = *(const unsigned*)(sp + (size_t)(j0 + j) * 128);
#pragma unroll
                for (int j = 0; j < 16; ++j) { *(unsigned*)(xp + (size_t)(j0 + j) * UXLD) = cvtpk(xr, xi);
                    const float nr = ar * xr - ai * xi + bflo(sv[j]), ni = ar * xi + ai * xr + bfhi(sv[j]); xr = nr; xi = ni; }
            }
        }
      }
    }
    xcd_barrier(xbar);
    REP(9) if (PHMASK & (1 << 9)) {
        pg8::Gemm g{UX, BW2, UXLD, UXLD, UXLD, (size_t)NCH * UXLD, (size_t)256 * UXLD}; pg8::BatchOrder S{G, bx};
        EpiY E{UX, P.dsk, Yb, mkxs()};
        pg8::gemm_phase(lds, g, S, E, wave);
    }
    xcd_barrier(xbar);
    REP(10) if (PHMASK & (1 << 10)) {
        pg8::Gemm g{Yb, Wglu_t, DM, DM, DM, 0, 0}; pg8::StaticOrder S; S.init(MREAL, 2 * DM, G, bx);
        EpiGLU E{HA, HB, SS3, mkxs()};
        pg8::gemm_phase(lds, g, S, E, wave);
    }
    xcd_barrier(xbar);
    REP(11) if (PHMASK & (1 << 11)) {
        pg8::Gemm g{HB, Wup1_t, DM, DM, DM, 0, 0}; pg8::StaticOrder S; S.init(MREAL, FF, G, bx);
        EpiUp<32> E{SS3, ACT, mkxs()};
        pg8::gemm_phase(lds, g, S, E, wave, STAG_UP);
    }
    xcd_barrier(xbar);
    REP(12) if (PHMASK & (1 << 12)) {
        pg8::Gemm g{ACT, Wdn1_t, FF, FF, FF, 0, 0}; pg8::StaticOrder S; S.init(MREAL, DM, G, bx);
        EpiResid E{HB, HA, SS4, mkxs()};
        pg8::gemm_phase(lds, g, S, E, wave);
    }
    xcd_barrier(xbar);
    for (int xs_ = 0; xs_ < XSYNC; ++xs_) xcd_barrier(xbar);
    REP(13) if (PHMASK & (1 << 13)) {
        const int t_ = fresh_tid(wave); const int tid = t_, lane = tid & 63; (void)tid; (void)lane;
      for (int m = gw; m < MREAL; m += NGW) {
        const float sl = (lane < 16) ? SS4[(size_t)m * 16 + lane] : 0.f;
        const float rs = 1.0f / sqrtf(wave_sum(sl) * (1.0f / DM) + EPS);
        const u32x4* hp = (const u32x4*)(HA + (size_t)m * DM);
        f32x4* op = (f32x4*)(P.out + (size_t)m * DM);
#pragma unroll
        for (int j = 0; j < 2; ++j) { f32x4 v0, v1; unpack8(hp[64 * j + lane], v0, v1);
            const f32x4 w0 = *(const f32x4*)(P.fnw + (64 * j + lane) * 8), w1 = *(const f32x4*)(P.fnw + (64 * j + lane) * 8 + 4);
            op[(64 * j + lane) * 2] = v0 * rs * w0; op[(64 * j + lane) * 2 + 1] = v1 * rs * w1; }
      }
    }
}

extern "C" void kernel_launch(void* const* d_in, const int* in_sizes, int n_in, void* d_out, int out_size, void* d_ws, size_t ws_size, hipStream_t stream) {
    static int grid = 0;
    if (grid == 0) {
        if (n_in != 20 || ws_size < WS_END) { fprintf(stderr, "kernel_launch: unexpected n_in %d or ws_size %zu (need %zu)\n", n_in, ws_size, (size_t)WS_END); grid = -1; return; }
        int dev = 0, cus = 0, per_cu = 0;
        hipGetDevice(&dev); hipDeviceGetAttribute(&cus, hipDeviceAttributeMultiprocessorCount, dev);
        hipFuncSetAttribute((const void*)fwd_kernel, hipFuncAttributeMaxDynamicSharedMemorySize, LDS_BYTES);
        hipOccupancyMaxActiveBlocksPerMultiprocessor(&per_cu, (const void*)fwd_kernel, 512, LDS_BYTES);
        if (per_cu < 1) { fprintf(stderr, "kernel_launch: occupancy query says %d blocks/CU\n", per_cu); per_cu = 1; }
        (void)hipGetLastError();
        grid = cus;
    }
    if (grid < 0) return;
    Params p{};
    p.x = (const float*)d_in[0]; p.meta = (const float*)d_in[1]; p.attn_nw = (const float*)d_in[2]; p.wqkv = (const float*)d_in[3]; p.sinks = (const float*)d_in[4]; p.wo = (const float*)d_in[5];
    p.ssm_nw = (const float*)d_in[6]; p.lre = (const float*)d_in[7]; p.lim = (const float*)d_in[8]; p.logdt = (const float*)d_in[9]; p.bre = (const float*)d_in[10]; p.bim = (const float*)d_in[11];
    p.cre = (const float*)d_in[12]; p.cim = (const float*)d_in[13]; p.dsk = (const float*)d_in[14]; p.wglu = (const float*)d_in[15]; p.mlp_nw = (const float*)d_in[16]; p.wup = (const float*)d_in[17];
    p.wdn = (const float*)d_in[18]; p.fnw = (const float*)d_in[19]; p.out = (float*)d_out; p.ws = (unsigned char*)d_ws;
    if (hipMemsetAsync((char*)d_ws + WS_CTL, 0, XCD_BAR_WORDS * 4, stream) != hipSuccess) { fprintf(stderr, "kernel_launch: memset failed\n"); return; }
    void* args[] = {&p};
    hipError_t e = hipLaunchCooperativeKernel((const void*)fwd_kernel, dim3(grid), dim3(512), args, LDS_BYTES, stream);
    if (e != hipSuccess) fprintf(stderr, "cooperative launch failed: %s (grid %d)\n", hipGetErrorString(e), grid);
}
```
